# Optimizing an MI355X kernel written in HIP

```python
import math
import jax, jax.numpy as jnp
from jax import lax
import numpy as np

D_MODEL = 1024
BATCH = 2
SEQ = 8192
DEPTH = 4
DEC_BATCH = 4
DEC_SEQ = 4096
PAST_LEN = 128

N_EVEN = (DEPTH + 1) // 2
N_ODD = DEPTH // 2
D_FF = 2816
EPS = 1e-6
BLOCK = 128

D_CONV = 512
CONV_A_WIDTH = 3

MLA_HEADS = 8
QK_NOPE = 64
QK_ROPE = 32
V_DIM = 64
Q_RANK = 384
KV_RANK = 256
ROPE_THETA = 10000.0

EVEN_IN = 3 * D_CONV + Q_RANK + KV_RANK + QK_ROPE
EVEN_MIX = D_CONV + MLA_HEADS * V_DIM

D_RNN = 512
LRU_BLOCKS = 8
LRU_BW = D_RNN // LRU_BLOCKS
CONV_C_WIDTH = 4
LRU_C = 8.0

SWA_HEADS = 8
SWA_KV_HEADS = 2
SWA_HD = 64
WINDOW = 128

ODD_IN = 2 * D_RNN + (SWA_HEADS + 2 * SWA_KV_HEADS) * SWA_HD
ODD_MIX = D_RNN + SWA_HEADS * SWA_HD

kernel_name = "hybrid_bidir_conv_mla_rglru_swa_macaron"


def rmsnorm(x, g):
    xf = x.astype(jnp.float32)
    y = xf * lax.rsqrt(jnp.mean(xf * xf, axis=-1, keepdims=True) + EPS)
    return (y * g.astype(jnp.float32)).astype(x.dtype)


def swiglu(x, w_gate, w_up, w_down):
    return (jax.nn.silu(x @ w_gate) * (x @ w_up)) @ w_down


def dwconv(x, w, pad_left, pad_right):
    return lax.conv_general_dilated(
        x, w[:, None, :].astype(x.dtype), window_strides=(1,),
        padding=[(pad_left, pad_right)], dimension_numbers=('NWC', 'WIO', 'NWC'),
        feature_group_count=x.shape[-1])


def rope(x, positions):
    half = x.shape[-1] // 2
    inv = ROPE_THETA ** (-jnp.arange(half, dtype=jnp.float32) / half)
    ang = positions.astype(jnp.float32)[:, None] * inv[None, :]
    cos = jnp.cos(ang)[:, None, :]
    sin = jnp.sin(ang)[:, None, :]
    x1 = x[..., :half].astype(jnp.float32)
    x2 = x[..., half:].astype(jnp.float32)
    return jnp.concatenate([x1 * cos - x2 * sin, x1 * sin + x2 * cos], axis=-1).astype(x.dtype)


def mla(q_lat, kv_lat, k_rope_raw, q_norm, w_uq, kv_norm, w_ukv):
    B, S, _ = q_lat.shape
    pos = jnp.arange(S)
    q = (rmsnorm(q_lat, q_norm) @ w_uq).reshape(B, S, MLA_HEADS, QK_NOPE + QK_ROPE)
    q_nope, q_pe = q[..., :QK_NOPE], rope(q[..., QK_NOPE:], pos)
    kv = (rmsnorm(kv_lat, kv_norm) @ w_ukv).reshape(B, S, MLA_HEADS, QK_NOPE + V_DIM)
    k_nope, v = kv[..., :QK_NOPE], kv[..., QK_NOPE:]
    k_pe = rope(k_rope_raw[:, :, None, :], pos)[:, :, 0, :]
    scale = (QK_NOPE + QK_ROPE) ** -0.5
    nblk = S // BLOCK
    qn_b = q_nope.reshape(B, nblk, BLOCK, MLA_HEADS, QK_NOPE).transpose(1, 0, 2, 3, 4)
    qp_b = q_pe.reshape(B, nblk, BLOCK, MLA_HEADS, QK_ROPE).transpose(1, 0, 2, 3, 4)

    def attend(blk):
        qn, qp = blk
        s = jnp.einsum('bqhd,bkhd->bhqk', qn, k_nope) + jnp.einsum('bqhr,bkr->bhqk', qp, k_pe)
        p = jax.nn.softmax(s.astype(jnp.float32) * scale, axis=-1).astype(v.dtype)
        return jnp.einsum('bhqk,bkhd->bqhd', p, v)

    o = lax.map(attend, (qn_b, qp_b))
    return o.transpose(1, 0, 2, 3, 4).reshape(B, S, MLA_HEADS * V_DIM)


def rglru_direction(x, w_a, b_a, w_x, b_x, lam, reverse):
    B, S, _ = x.shape
    xb = x.reshape(B, S, LRU_BLOCKS, LRU_BW)
    r = jax.nn.sigmoid(jnp.einsum('bsnc,ncd->bsnd', xb, w_a).reshape(B, S, D_RNN) + b_a)
    i = jax.nn.sigmoid(jnp.einsum('bsnc,ncd->bsnd', xb, w_x).reshape(B, S, D_RNN) + b_x)
    log_a = -LRU_C * r.astype(jnp.float32) * jax.nn.softplus(-lam.astype(jnp.float32))
    a = jnp.exp(log_a)
    u = jnp.sqrt(-jnp.expm1(2.0 * log_a)) * (i * x).astype(jnp.float32)

    def combine(left, right):
        a_l, b_l = left
        a_r, b_r = right
        return a_l * a_r, a_r * b_l + b_r

    _, h = lax.associative_scan(combine, (a, u), axis=1, reverse=reverse)
    return h.astype(x.dtype)


def windowed_gqa(q, k, v, sink):
    B, S, _ = q.shape
    nblk = S // BLOCK
    G = SWA_HEADS // SWA_KV_HEADS
    qb = q.reshape(B, nblk, BLOCK, SWA_KV_HEADS, G, SWA_HD)
    pad = ((0, 0), (BLOCK, BLOCK), (0, 0), (0, 0))
    kp = jnp.pad(k.reshape(B, S, SWA_KV_HEADS, SWA_HD), pad).reshape(B, nblk + 2, BLOCK, SWA_KV_HEADS, SWA_HD)
    vp = jnp.pad(v.reshape(B, S, SWA_KV_HEADS, SWA_HD), pad).reshape(B, nblk + 2, BLOCK, SWA_KV_HEADS, SWA_HD)
    kw = jnp.concatenate([kp[:, :-2], kp[:, 1:-1], kp[:, 2:]], axis=2)
    vw = jnp.concatenate([vp[:, :-2], vp[:, 1:-1], vp[:, 2:]], axis=2)
    s = jnp.einsum('bnqkgd,bnckd->bnkgqc', qb, kw).astype(jnp.float32) * (SWA_HD ** -0.5)
    qi = jnp.arange(BLOCK)[:, None]
    ci = jnp.arange(3 * BLOCK)[None, :]
    rel = jnp.abs(ci - BLOCK - qi)
    key_pos = jnp.arange(nblk)[:, None] * BLOCK - BLOCK + jnp.arange(3 * BLOCK)[None, :]
    valid = (rel <= WINDOW)[None] & ((key_pos >= 0) & (key_pos < S))[:, None, :]
    slopes = (2.0 ** (-8.0 * jnp.arange(1, SWA_HEADS + 1, dtype=jnp.float32) / SWA_HEADS)).reshape(SWA_KV_HEADS, G)
    s = s - slopes[:, :, None, None] * rel.astype(jnp.float32)
    s = jnp.where(valid[None, :, None, None], s, -jnp.inf)
    sk = sink.astype(jnp.float32).reshape(SWA_KV_HEADS, G)[None, None, :, :, None, None]
    m = jnp.maximum(jnp.max(s, axis=-1, keepdims=True), sk)
    e = jnp.exp(s - m)
    p = e / (jnp.sum(e, axis=-1, keepdims=True) + jnp.exp(sk - m))
    o = jnp.einsum('bnkgqc,bnckd->bnqkgd', p.astype(v.dtype), vw)
    return o.reshape(B, S, SWA_HEADS * SWA_HD)


def even_mixer(h, w_in, conv_w, q_norm, w_uq, kv_norm, w_ukv, w_out):
    z = h @ w_in
    b_g, c_g, xa, q_lat, kv_lat, k_r = jnp.split(
        z, [D_CONV, 2 * D_CONV, 3 * D_CONV, 3 * D_CONV + Q_RANK, 3 * D_CONV + Q_RANK + KV_RANK], axis=-1)
    y_a = b_g * dwconv(c_g * xa, conv_w, 1, 1)
    y_b = mla(q_lat, kv_lat, k_r, q_norm, w_uq, kv_norm, w_ukv)
    return jnp.concatenate([y_a, y_b], axis=-1) @ w_out


def odd_mixer(h, w_in, conv_w, conv_b, w_a, b_a, w_x, b_x, lam, sink, w_out):
    z = h @ w_in
    qd = SWA_HEADS * SWA_HD
    kd = SWA_KV_HEADS * SWA_HD
    xr, gate, q, k, v = jnp.split(z, [D_RNN, 2 * D_RNN, 2 * D_RNN + qd, 2 * D_RNN + qd + kd], axis=-1)
    xr = dwconv(xr, conv_w, 2, 1) + conv_b
    hr = (rglru_direction(xr, w_a[0], b_a[0], w_x[0], b_x[0], lam[0], False)
          + rglru_direction(xr, w_a[1], b_a[1], w_x[1], b_x[1], lam[1], True))
    y_c = jax.nn.gelu(gate) * hr
    y_d = windowed_gqa(q, k, v, sink)
    return jnp.concatenate([y_c, y_d], axis=-1) @ w_out


def trunk(x, ffn_norm, ffn_w_gate, ffn_w_up, ffn_w_down, mix_norm,
          ev_w_in, ev_conv_w, mla_q_norm, mla_w_uq, mla_kv_norm, mla_w_ukv, ev_w_out,
          od_w_in, od_conv_w, od_conv_b, lru_w_a, lru_b_a, lru_w_x, lru_b_x, lru_lambda,
          swa_sink, od_w_out, final_norm):
    for l in range(DEPTH):
        j = l // 2
        x = x + 0.5 * swiglu(rmsnorm(x, ffn_norm[l, 0]), ffn_w_gate[l, 0], ffn_w_up[l, 0], ffn_w_down[l, 0])
        h = rmsnorm(x, mix_norm[l])
        if l % 2 == 0:
            x = x + even_mixer(h, ev_w_in[j], ev_conv_w[j], mla_q_norm[j], mla_w_uq[j],
                               mla_kv_norm[j], mla_w_ukv[j], ev_w_out[j])
        else:
            x = x + odd_mixer(h, od_w_in[j], od_conv_w[j], od_conv_b[j], lru_w_a[j], lru_b_a[j],
                              lru_w_x[j], lru_b_x[j], lru_lambda[j], swa_sink[j], od_w_out[j])
        x = x + 0.5 * swiglu(rmsnorm(x, ffn_norm[l, 1]), ffn_w_gate[l, 1], ffn_w_up[l, 1], ffn_w_down[l, 1])
    return rmsnorm(x, final_norm)


def setup_inputs(seed: int = 0) -> dict:
    key = jax.random.key(seed)
    ks = jax.random.split(key, 26)
    f32 = jnp.float32

    def nrm(k, shape, scale):
        return jax.random.normal(k, shape, f32) * scale

    def gain(k, shape):
        return 1.0 + 0.02 * jax.random.normal(k, shape, f32)

    u = jax.random.uniform(ks[21], (N_ODD, 2, D_RNN), f32, minval=0.9, maxval=0.999)
    p = u ** (1.0 / LRU_C)
    lam = jnp.log(p) - jnp.log1p(-p)
    return {
        "x_prompt": nrm(ks[0], (BATCH, SEQ, D_MODEL), 1.0),
        "x_sample": nrm(ks[1], (DEC_BATCH, DEC_SEQ, D_MODEL), 1.0),
        "ffn_norm": gain(ks[2], (DEPTH, 2, D_MODEL)),
        "ffn_w_gate": nrm(ks[3], (DEPTH, 2, D_MODEL, D_FF), D_MODEL ** -0.5),
        "ffn_w_up": nrm(ks[4], (DEPTH, 2, D_MODEL, D_FF), D_MODEL ** -0.5),
        "ffn_w_down": nrm(ks[5], (DEPTH, 2, D_FF, D_MODEL), D_FF ** -0.5),
        "mix_norm": gain(ks[6], (DEPTH, D_MODEL)),
        "ev_w_in": nrm(ks[7], (N_EVEN, D_MODEL, EVEN_IN), D_MODEL ** -0.5),
        "ev_conv_w": nrm(ks[8], (N_EVEN, CONV_A_WIDTH, D_CONV), CONV_A_WIDTH ** -0.5),
        "mla_q_norm": gain(ks[9], (N_EVEN, Q_RANK)),
        "mla_w_uq": nrm(ks[10], (N_EVEN, Q_RANK, MLA_HEADS * (QK_NOPE + QK_ROPE)), Q_RANK ** -0.5),
        "mla_kv_norm": gain(ks[11], (N_EVEN, KV_RANK)),
        "mla_w_ukv": nrm(ks[12], (N_EVEN, KV_RANK, MLA_HEADS * (QK_NOPE + V_DIM)), KV_RANK ** -0.5),
        "ev_w_out": nrm(ks[13], (N_EVEN, EVEN_MIX, D_MODEL), EVEN_MIX ** -0.5),
        "od_w_in": nrm(ks[14], (N_ODD, D_MODEL, ODD_IN), D_MODEL ** -0.5),
        "od_conv_w": nrm(ks[15], (N_ODD, CONV_C_WIDTH, D_RNN), CONV_C_WIDTH ** -0.5),
        "od_conv_b": nrm(ks[16], (N_ODD, D_RNN), 0.01),
        "lru_w_a": nrm(ks[17], (N_ODD, 2, LRU_BLOCKS, LRU_BW, LRU_BW), LRU_BW ** -0.5),
        "lru_b_a": nrm(ks[18], (N_ODD, 2, D_RNN), 0.01),
        "lru_w_x": nrm(ks[19], (N_ODD, 2, LRU_BLOCKS, LRU_BW, LRU_BW), LRU_BW ** -0.5),
        "lru_b_x": nrm(ks[20], (N_ODD, 2, D_RNN), 0.01),
        "lru_lambda": lam,
        "swa_sink": nrm(ks[22], (N_ODD, SWA_HEADS), 0.5),
        "od_w_out": nrm(ks[23], (N_ODD, ODD_MIX, D_MODEL), ODD_MIX ** -0.5),
        "final_norm": gain(ks[24], (D_MODEL,)),
    }


def reference(x_prompt, x_sample, ffn_norm, ffn_w_gate, ffn_w_up, ffn_w_down, mix_norm,
              ev_w_in, ev_conv_w, mla_q_norm, mla_w_uq, mla_kv_norm, mla_w_ukv, ev_w_out,
              od_w_in, od_conv_w, od_conv_b, lru_w_a, lru_b_a, lru_w_x, lru_b_x, lru_lambda,
              swa_sink, od_w_out, final_norm):
    y_prompt = trunk(x_prompt, ffn_norm, ffn_w_gate, ffn_w_up, ffn_w_down, mix_norm,
                     ev_w_in, ev_conv_w, mla_q_norm, mla_w_uq, mla_kv_norm, mla_w_ukv, ev_w_out,
                     od_w_in, od_conv_w, od_conv_b, lru_w_a, lru_b_a, lru_w_x, lru_b_x, lru_lambda,
                     swa_sink, od_w_out, final_norm)
    y_sample = trunk(x_sample, ffn_norm, ffn_w_gate, ffn_w_up, ffn_w_down, mix_norm,
                     ev_w_in, ev_conv_w, mla_q_norm, mla_w_uq, mla_kv_norm, mla_w_ukv, ev_w_out,
                     od_w_in, od_conv_w, od_conv_b, lru_w_a, lru_b_a, lru_w_x, lru_b_x, lru_lambda,
                     swa_sink, od_w_out, final_norm)
    return (y_prompt, y_sample)
```

```cpp
#include <hip/hip_runtime.h>
#include <hip/hip_cooperative_groups.h>
#include <cstdio>
#include <cstdint>
namespace cg = cooperative_groups;

#ifndef MK_MULTI
#define MK_MULTI 0
#endif

#define LAS __attribute__((address_space(3)))
typedef unsigned short bf16_t;
typedef short bf16x8 __attribute__((ext_vector_type(8)));
typedef short s16x4 __attribute__((ext_vector_type(4)));
typedef float f32x2 __attribute__((ext_vector_type(2)));
typedef float f32x4 __attribute__((ext_vector_type(4)));
typedef float f32x16 __attribute__((ext_vector_type(16)));
typedef unsigned u32x2 __attribute__((ext_vector_type(2)));
typedef unsigned u32x4 __attribute__((ext_vector_type(4)));

constexpr int T = 32768, TP = 16384, DM = 1024, FF = 2816;
constexpr int EV_IN = 2208, EV_INP = 2304, OD_IN = 1792;
constexpr float LOG2E = 1.4426950408889634f;
constexpr float EPS = 1e-6f;

constexpr size_t MiB = 1u << 20;
constexpr size_t WS_ROPE = 0, WS_AGG = 1 * MiB, WS_BAR = 7 * MiB, BAR_BYTES = 32768, WS_W = 7 * MiB + 65536, WS_XN = 170 * MiB, WS_BIG = 234 * MiB, WS_END = 442 * MiB;
constexpr size_t W_GU = 0, W_GU_SZ = (size_t)5632 * 1024;
constexpr size_t W_DN = W_GU + 8 * W_GU_SZ, W_DN_SZ = (size_t)1024 * 2816;
constexpr size_t W_EVIN = W_DN + 8 * W_DN_SZ, W_EVIN_SZ = (size_t)EV_INP * 1024;
constexpr size_t W_UQ = W_EVIN + 2 * W_EVIN_SZ, W_UQ_SZ = (size_t)768 * 384;
constexpr size_t W_UKV = W_UQ + 2 * W_UQ_SZ, W_UKV_SZ = (size_t)1024 * 256;
constexpr size_t W_EVOUT = W_UKV + 2 * W_UKV_SZ, W_SQ_SZ = (size_t)1024 * 1024;
constexpr size_t W_ODIN = W_EVOUT + 2 * W_SQ_SZ, W_ODIN_SZ = (size_t)OD_IN * 1024;
constexpr size_t W_LRU = W_ODIN + 2 * W_ODIN_SZ, W_LRU_SZ = (size_t)2048 * 512;
constexpr size_t W_ODOUT = W_LRU + 2 * W_LRU_SZ;
constexpr size_t W_TOTAL = W_ODOUT + 2 * W_SQ_SZ;
static_assert(WS_W + W_TOTAL * 2 <= WS_XN, "weights fit");
constexpr size_t B_ACT = 0;
constexpr int ZLD = 2816;
constexpr size_t B_Z = 0, O_Q = 64 * MiB, O_KPE = 112 * MiB;
constexpr size_t B_Z2 = 0, B_XC = 176 * MiB, O_U = 64 * MiB;

constexpr int LDS_BYTES = 147456;
constexpr int NTHREADS = 512;

__device__ __forceinline__ unsigned cvt_pk_bf16(float lo, float hi) { unsigned r; asm volatile("v_cvt_pk_bf16_f32 %0, %1, %2" : "=v"(r) : "v"(lo), "v"(hi)); return r; }
__device__ __forceinline__ float bf_lo(unsigned w) { return __uint_as_float(w << 16); }
__device__ __forceinline__ float bf_hi(unsigned w) { return __uint_as_float(w & 0xffff0000u); }
__device__ __forceinline__ float bf2f(bf16_t b) { return __uint_as_float((unsigned)b << 16); }
template <int O> __device__ __forceinline__ float swz_xor(float v) { return __builtin_bit_cast(float, __builtin_amdgcn_ds_swizzle(__builtin_bit_cast(int, v), 0x1F | (O << 10))); }
__device__ __forceinline__ float wave_sum(float v) {
    v += swz_xor<1>(v); v += swz_xor<2>(v); v += swz_xor<4>(v); v += swz_xor<8>(v); v += swz_xor<16>(v);
    auto rr = __builtin_amdgcn_permlane32_swap(__float_as_uint(v), __float_as_uint(v), false, false);
    return __uint_as_float(rr[0]) + __uint_as_float(rr[1]);
}
__device__ __forceinline__ float fq_sum(float v) {
    v += swz_xor<16>(v);
    auto rr = __builtin_amdgcn_permlane32_swap(__float_as_uint(v), __float_as_uint(v), false, false);
    return __uint_as_float(rr[0]) + __uint_as_float(rr[1]);
}
__device__ __forceinline__ float row_rstd(const float* part, int row, int fq) {
    const f32x4 p = *(const f32x4*)(part + (size_t)row * 16 + 4 * fq);
    return rsqrtf(fq_sum((p.x + p.y) + (p.z + p.w)) * (1.f / DM) + EPS);
}
__device__ __forceinline__ float sigmoidf_(float x) { return __builtin_amdgcn_rcpf(1.0f + __builtin_amdgcn_exp2f(-x * LOG2E)); }

namespace pg8 {
constexpr int BM = 256, BK = 64, HALF = 128, HTB = HALF * BK * 2, STAGE_BYTES = 8 * HTB, NXCD = 8, WGM = 8;
__host__ __device__ __forceinline__ int lds_byte(int r, int c) { const int st = (r >> 4) * 2 + (c >> 5), rr = r & 15, cc = c & 31, ob = rr * 64 + cc * 2; return st * 1024 + (ob ^ (((ob >> 9) & 1) << 5)); }
__host__ __device__ __forceinline__ void stage_rc(int b, int& R, int& C) { const int st = b / 1024, sb = b % 1024, swz = sb ^ (((sb >> 9) & 1) << 5); R = (st >> 1) * 16 + swz / 64; C = (st & 1) * 32 + (swz % 64) / 2; }
__host__ __device__ __forceinline__ int perm32(int rho) { const int n = rho >> 4, i = rho & 15; return 8 * (i >> 2) + 4 * n + (i & 3); }

struct Unit { int pm, pn; };
struct Gemm { const bf16_t* A; const bf16_t* Bt; int lda, M, N, K, kslice; };

struct StaticOrder {
    int nM, nN, nwg, G, c;
    __device__ void init(int M, int N, int G_, int c_) { nM = M / BM; nN = N / BM; nwg = nM * nN; G = G_; c = c_; }
    __device__ bool next(int i, Unit& u) const {
        const long L = (long)i * G + c; if (L >= nwg) return false;
        int wgid = (int)L; { const int q = nwg / NXCD, r = nwg % NXCD, xcd = wgid % NXCD, off = wgid / NXCD; wgid = (xcd < r ? xcd * (q + 1) : r * (q + 1) + (xcd - r) * q) + off; }
        const int nig = WGM * nN, gid = wgid / nig, fm = gid * WGM, gsz = (nM - fm) < WGM ? (nM - fm) : WGM;
        u.pm = fm + ((wgid % nig) % gsz); u.pn = (wgid % nig) / gsz; return true;
    }
};

template <class Epi, bool ALIGN_EPI>
__device__ __forceinline__ void gemm_phase(LAS unsigned char* lds, const Gemm g, const StaticOrder S, const Epi E) {
    int tid = threadIdx.x; asm volatile("" : "+v"(tid));
    const int wid = __builtin_amdgcn_readfirstlane(tid >> 6), lane = tid & 63, wr = wid >> 2, wc = wid & 3, fr = lane & 15, fq = lane >> 4;
    const int K = g.K, nt = (g.kslice ? g.kslice : K) / BK, lda = g.lda;
#define PG8_KOFS(u_) (g.kslice ? (size_t)((u_).pn & 3) * (size_t)g.kslice * 2 : (size_t)0)
    unsigned voffA[2], voffB[2];
#pragma unroll
    for (int i = 0; i < 2; ++i) { int R, C; stage_rc(tid * 16 + i * 8192, R, C); const int Rb = Epi::PERM ? ((R & ~31) + perm32(R & 31)) : R;
        voffA[i] = (unsigned)(R * lda + C) * 2u; voffB[i] = (unsigned)(Rb * K + C) * 2u; }
    const size_t kstep = (size_t)(BK * 2);
    const size_t hstepA = (size_t)HALF * lda * 2, hstepB = (size_t)HALF * K * 2;
    const size_t tstepA = 2 * hstepA, tstepB = 2 * hstepB;
    const unsigned ldsw = (unsigned)wid * 1024u;
    const int aoff = lds_byte(wr * 64 + fr, fq * 8), boff = lds_byte(wc * 32 + fr, fq * 8);
#define PG8_SA(b, h) (((b) * 2 + (h)) * HTB)
#define PG8_SB(b, h) ((4 + (b) * 2 + (h)) * HTB)
#define PG8_STAGE(bufoff, gbase, voff) do { _Pragma("unroll") for (int _i = 0; _i < 2; ++_i) \
        __builtin_amdgcn_global_load_lds((const unsigned*)((const char*)(gbase) + (voff)[_i]), (LAS unsigned*)(lds + (bufoff) + ldsw + _i * 8192), 16, 0, 0); } while (0)
#define PG8_LDA(dst, b, h) do { _Pragma("unroll") for (int m = 0; m < 4; ++m) _Pragma("unroll") for (int k = 0; k < 2; ++k) dst[m][k] = *(const LAS bf16x8*)(lds + PG8_SA(b, h) + aoff + m * 2048 + k * 1024); } while (0)
#define PG8_LDB(dst, b, h) do { _Pragma("unroll") for (int n = 0; n < 2; ++n) _Pragma("unroll") for (int k = 0; k < 2; ++k) dst[n][k] = *(const LAS bf16x8*)(lds + PG8_SB(b, h) + boff + n * 2048 + k * 1024); } while (0)
#define PG8_MMA(ai, bj, At, Bt) do { __builtin_amdgcn_s_setprio(1); _Pragma("unroll") for (int m = 0; m < 4; ++m) _Pragma("unroll") for (int n = 0; n < 2; ++n) _Pragma("unroll") for (int k = 0; k < 2; ++k) \
        acc[ai][bj][m][n] = __builtin_amdgcn_mfma_f32_16x16x32_bf16(Bt[n][k], At[m][k], acc[ai][bj][m][n], 0, 0, 0); __builtin_amdgcn_s_setprio(0); } while (0)
#define PG8_WAIT_V(n) asm volatile("s_waitcnt vmcnt(" #n ")" ::: "memory")
#define PG8_WAIT_L(n) asm volatile("s_waitcnt lgkmcnt(" #n ")" ::: "memory")
#define PG8_BAR __builtin_amdgcn_s_barrier()
#define PG8_SCHED __builtin_amdgcn_sched_barrier(0)
    Unit cur, nxt; int ui = 0;
    if (!S.next(0, cur)) return;
    float rs[2][4], rsp[2][4];
#define PG8_RS_ISSUE(u_) do { if constexpr (Epi::ROWSCALE) { _Pragma("unroll") for (int ai_ = 0; ai_ < 2; ++ai_) _Pragma("unroll") for (int m_ = 0; m_ < 4; ++m_) { \
        const f32x4 p_ = *(const f32x4*)(E.part + (size_t)((u_).pm * BM + ai_ * HALF + wr * 64 + m_ * 16 + fr) * 16 + 4 * fq); rsp[ai_][m_] = (p_.x + p_.y) + (p_.z + p_.w); } } } while (0)
#define PG8_RS_FINISH() do { if constexpr (Epi::ROWSCALE) { _Pragma("unroll") for (int ai_ = 0; ai_ < 2; ++ai_) _Pragma("unroll") for (int m_ = 0; m_ < 4; ++m_) rs[ai_][m_] = rsqrtf(fq_sum(rsp[ai_][m_]) * (1.f / DM) + EPS); } \
        else { _Pragma("unroll") for (int ai_ = 0; ai_ < 2; ++ai_) _Pragma("unroll") for (int m_ = 0; m_ < 4; ++m_) rs[ai_][m_] = 1.f; } } while (0)
    PG8_RS_ISSUE(cur);
    f32x4 acc[2][2][4][2];
#pragma unroll
    for (int a = 0; a < 2; ++a)
#pragma unroll
        for (int b = 0; b < 2; ++b)
#pragma unroll
            for (int m = 0; m < 4; ++m)
#pragma unroll
                for (int n = 0; n < 2; ++n) acc[a][b][m][n] = (f32x4){0.f, 0.f, 0.f, 0.f};
    bf16x8 At[4][2], B0[2][2], B1[2][2];
    const char* cA = (const char*)g.A + (size_t)cur.pm * tstepA + PG8_KOFS(cur); const char* cB = (const char*)g.Bt + (size_t)cur.pn * tstepB + PG8_KOFS(cur);
    PG8_STAGE(PG8_SB(0, 0), cB, voffB); PG8_STAGE(PG8_SB(0, 1), cB + hstepB, voffB); PG8_STAGE(PG8_SA(0, 0), cA, voffA); PG8_STAGE(PG8_SA(0, 1), cA + hstepA, voffA);
    if (wr == 1) PG8_BAR;
    PG8_WAIT_V(2); PG8_BAR;
    PG8_STAGE(PG8_SB(1, 0), cB + kstep, voffB); PG8_STAGE(PG8_SA(1, 0), cA + kstep, voffA); PG8_STAGE(PG8_SB(1, 1), cB + hstepB + kstep, voffB);
    PG8_WAIT_V(6); PG8_BAR;
    PG8_RS_FINISH();
    for (;;) {
        const bool has_next = S.next(ui + 1, nxt);
        const char* nA = has_next ? (const char*)g.A + (size_t)nxt.pm * tstepA + PG8_KOFS(nxt) : cA; const char* nB = has_next ? (const char*)g.Bt + (size_t)nxt.pn * tstepB + PG8_KOFS(nxt) : cB;
#pragma unroll 1
        for (int t = 0; t < nt; t += 2) {
            const bool last = (t == nt - 2);
            const char* a1 = cA + (size_t)(t + 1) * kstep;
            const char* a2 = last ? nA : cA + (size_t)(t + 2) * kstep; const char* b2 = last ? nB : cB + (size_t)(t + 2) * kstep;
            const char* a3 = a2 + kstep; const char* b3 = b2 + kstep;
            PG8_LDB(B0, 0, 0); PG8_LDB(B1, 0, 1); PG8_SCHED; PG8_LDA(At, 0, 0); PG8_STAGE(PG8_SA(1, 1), a1 + hstepA, voffA);
            PG8_WAIT_V(8); PG8_WAIT_L(0); PG8_BAR; PG8_MMA(0, 0, At, B0); PG8_MMA(0, 1, At, B1); PG8_BAR; PG8_SCHED;
            PG8_LDA(At, 0, 1); PG8_STAGE(PG8_SB(0, 0), b2, voffB); PG8_STAGE(PG8_SB(0, 1), b2 + hstepB, voffB); PG8_STAGE(PG8_SA(0, 0), a2, voffA);
            PG8_WAIT_V(8); PG8_WAIT_L(0); PG8_BAR; PG8_MMA(1, 0, At, B0); PG8_MMA(1, 1, At, B1); PG8_BAR; PG8_SCHED;
            PG8_LDB(B0, 1, 0); PG8_LDB(B1, 1, 1); PG8_SCHED; PG8_LDA(At, 1, 0); PG8_STAGE(PG8_SA(0, 1), a2 + hstepA, voffA);
            PG8_WAIT_V(8); PG8_WAIT_L(0); PG8_BAR; PG8_MMA(0, 0, At, B0); PG8_MMA(0, 1, At, B1); PG8_BAR; PG8_SCHED;
            PG8_LDA(At, 1, 1); PG8_STAGE(PG8_SB(1, 0), b3, voffB); PG8_STAGE(PG8_SB(1, 1), b3 + hstepB, voffB); PG8_STAGE(PG8_SA(1, 0), a3, voffA);
            PG8_WAIT_V(8); PG8_WAIT_L(0); PG8_BAR; PG8_MMA(1, 0, At, B0); PG8_MMA(1, 1, At, B1); PG8_BAR; PG8_SCHED;
        }
        if constexpr (ALIGN_EPI) { if (wr == 0) PG8_BAR; }
        if (has_next) PG8_RS_ISSUE(nxt);
        E(acc, cur, wr, wc, fr, fq, rs);
        if (!has_next) break;
        PG8_RS_FINISH();
#pragma unroll
        for (int a = 0; a < 2; ++a)
#pragma unroll
            for (int b = 0; b < 2; ++b)
#pragma unroll
                for (int m = 0; m < 4; ++m)
#pragma unroll
                    for (int n = 0; n < 2; ++n) acc[a][b][m][n] = (f32x4){0.f, 0.f, 0.f, 0.f};
        cur = nxt; cA = nA; cB = nB; ++ui;
        if constexpr (ALIGN_EPI) { if (wr == 1) PG8_BAR; }
    }
    PG8_WAIT_V(0);
    if constexpr (!ALIGN_EPI) { if (wr == 0) PG8_BAR; }
    PG8_BAR;
#undef PG8_KOFS
#undef PG8_RS_ISSUE
#undef PG8_RS_FINISH
#undef PG8_SA
#undef PG8_SB
#undef PG8_STAGE
#undef PG8_LDA
#undef PG8_LDB
#undef PG8_MMA
#undef PG8_WAIT_V
#undef PG8_WAIT_L
#undef PG8_BAR
#undef PG8_SCHED
}

template <bool SCALE> struct EpiStore {
    static constexpr bool PERM = true, ROWSCALE = SCALE;
    bf16_t* O; int ldc; const float* part;
    __device__ __forceinline__ void operator()(const f32x4 (&acc)[2][2][4][2], const Unit& u, int wr, int wc, int fr, int fq, const float (&rs)[2][4]) const {
        asm volatile("" : "+v"(fr), "+v"(fq));
        const int row0 = u.pm * BM + wr * 64 + fr, col0 = u.pn * BM + wc * 32 + 8 * fq;
#pragma unroll
        for (int ai = 0; ai < 2; ++ai)
#pragma unroll
            for (int m = 0; m < 4; ++m) { bf16_t* rowp = O + (size_t)(row0 + ai * HALF + m * 16) * ldc + col0;
                const float rsv = SCALE ? rs[ai][m] : 1.0f;
#pragma unroll
                for (int bj = 0; bj < 2; ++bj) { const f32x4 v0 = acc[ai][bj][m][0] * rsv, v1 = acc[ai][bj][m][1] * rsv;
                    u32x4 w; w.x = cvt_pk_bf16(v0[0], v0[1]); w.y = cvt_pk_bf16(v0[2], v0[3]); w.z = cvt_pk_bf16(v1[0], v1[1]); w.w = cvt_pk_bf16(v1[2], v1[3]);
                    *(u32x4*)(rowp + bj * HALF) = w; } }
    }
};
struct EpiSwiglu {
    static constexpr bool PERM = true, ROWSCALE = true;
    bf16_t* O; const float* part;
    __device__ __forceinline__ void operator()(const f32x4 (&acc)[2][2][4][2], const Unit& u, int wr, int wc, int fr, int fq, const float (&rs)[2][4]) const {
        asm volatile("" : "+v"(fr), "+v"(fq));
        const int row0 = u.pm * BM + wr * 64 + fr, col0 = u.pn * HALF + wc * 32 + 8 * fq;
#pragma unroll
        for (int ai = 0; ai < 2; ++ai)
#pragma unroll
            for (int m = 0; m < 4; ++m) { bf16_t* rowp = O + (size_t)(row0 + ai * HALF + m * 16) * FF + col0;
                float r[8], e[8]; const float rsv = rs[ai][m]; const float c1 = -rsv * LOG2E, c2 = rsv * rsv;
#pragma unroll
                for (int j = 0; j < 8; ++j) { const float gv = acc[ai][0][m][j >> 2][j & 3], uv = acc[ai][1][m][j >> 2][j & 3]; e[j] = gv * c1; r[j] = gv * uv; }
                __builtin_amdgcn_sched_barrier(0);
#pragma unroll
                for (int j = 0; j < 8; ++j) e[j] = __builtin_amdgcn_exp2f(e[j]);
                __builtin_amdgcn_sched_barrier(0);
#pragma unroll
                for (int j = 0; j < 8; ++j) e[j] = 1.0f + e[j];
                __builtin_amdgcn_sched_barrier(0);
#pragma unroll
                for (int j = 0; j < 8; ++j) e[j] = __builtin_amdgcn_rcpf(e[j]);
                __builtin_amdgcn_sched_barrier(0);
#pragma unroll
                for (int j = 0; j < 8; ++j) r[j] = r[j] * (c2 * e[j]);
                u32x4 w; w.x = cvt_pk_bf16(r[0], r[1]); w.y = cvt_pk_bf16(r[2], r[3]); w.z = cvt_pk_bf16(r[4], r[5]); w.w = cvt_pk_bf16(r[6], r[7]);
                *(u32x4*)rowp = w; }
    }
};
struct EpiRes {
    static constexpr bool PERM = true, ROWSCALE = false;
    bf16_t* X; float* part; float alpha;
    __device__ __forceinline__ void operator()(const f32x4 (&acc)[2][2][4][2], const Unit& u, int wr, int wc, int fr, int fq, const float (&rs)[2][4]) const {
        asm volatile("" : "+v"(fr), "+v"(fq));
        const int row0 = u.pm * BM + wr * 64 + fr, col0 = u.pn * BM + wc * 32 + 8 * fq;
#pragma unroll
        for (int ai = 0; ai < 2; ++ai) {
#pragma unroll
            for (int m = 0; m < 4; ++m) { bf16_t* rowp = X + (size_t)(row0 + ai * HALF + m * 16) * DM + col0; float ss = 0.f;
#pragma unroll
                for (int bj = 0; bj < 2; ++bj) { const u32x4 bw = *(const u32x4*)(rowp + bj * HALF); const f32x4 a0 = acc[ai][bj][m][0], a1 = acc[ai][bj][m][1];
                    u32x4 w; w.x = cvt_pk_bf16(bf_lo(bw.x) + alpha * a0[0], bf_hi(bw.x) + alpha * a0[1]); w.y = cvt_pk_bf16(bf_lo(bw.y) + alpha * a0[2], bf_hi(bw.y) + alpha * a0[3]);
                    w.z = cvt_pk_bf16(bf_lo(bw.z) + alpha * a1[0], bf_hi(bw.z) + alpha * a1[1]); w.w = cvt_pk_bf16(bf_lo(bw.w) + alpha * a1[2], bf_hi(bw.w) + alpha * a1[3]);
                    *(u32x4*)(rowp + bj * HALF) = w;
                    ss += (bf_lo(w.x) * bf_lo(w.x) + bf_hi(w.x) * bf_hi(w.x)) + (bf_lo(w.y) * bf_lo(w.y) + bf_hi(w.y) * bf_hi(w.y));
                    ss += (bf_lo(w.z) * bf_lo(w.z) + bf_hi(w.z) * bf_hi(w.z)) + (bf_lo(w.w) * bf_lo(w.w) + bf_hi(w.w) * bf_hi(w.w)); }
                ss = fq_sum(ss);
                if (fq == 0) part[(size_t)(row0 + ai * HALF + m * 16) * 16 + u.pn * 4 + wc] = ss; } }
    }
};
struct EpiQRope {
    static constexpr bool PERM = true, ROWSCALE = false;
    bf16_t* O; const float* tab;
    __device__ __forceinline__ void operator()(const f32x4 (&acc)[2][2][4][2], const Unit& u, int wr, int wc, int fr, int fq, const float (&rs)[2][4]) const {
        asm volatile("" : "+v"(fr), "+v"(fq));
        const int row0 = u.pm * BM + wr * 64 + fr;
        const int pmask = (u.pm < TP / BM) ? 8191 : 4095;
#pragma unroll
        for (int bj = 0; bj < 2; ++bj) {
            const int cb = u.pn * BM + bj * HALF + wc * 32 + 8 * fq; const int d = cb % 96; const bool rope = d >= 64; const int i0 = rope ? ((d - 64) >> 1) : 0;
#pragma unroll
            for (int ai = 0; ai < 2; ++ai)
#pragma unroll
                for (int m = 0; m < 4; ++m) { const int row = row0 + ai * HALF + m * 16; f32x4 v0 = acc[ai][bj][m][0], v1 = acc[ai][bj][m][1];
                    if (rope) { const float* cs = tab + ((size_t)(row & pmask) * 16 + i0) * 2; const f32x4 c01 = *(const f32x4*)cs, c23 = *(const f32x4*)(cs + 4);
                        const f32x4 a = v0, b = v1;
                        v0[0] = a[0] * c01[0] - a[1] * c01[1]; v0[1] = a[0] * c01[1] + a[1] * c01[0];
                        v0[2] = a[2] * c01[2] - a[3] * c01[3]; v0[3] = a[2] * c01[3] + a[3] * c01[2];
                        v1[0] = b[0] * c23[0] - b[1] * c23[1]; v1[1] = b[0] * c23[1] + b[1] * c23[0];
                        v1[2] = b[2] * c23[2] - b[3] * c23[3]; v1[3] = b[2] * c23[3] + b[3] * c23[2]; }
                    u32x4 w; w.x = cvt_pk_bf16(v0[0], v0[1]); w.y = cvt_pk_bf16(v0[2], v0[3]); w.z = cvt_pk_bf16(v1[0], v1[1]); w.w = cvt_pk_bf16(v1[2], v1[3]);
                    *(u32x4*)(O + (size_t)row * 768 + cb) = w;
                    asm volatile("" ::: "memory"); }
        }
    }
};
struct EpiLru {
    static constexpr bool PERM = true, ROWSCALE = false;
    bf16_t* LA; bf16_t* U; const bf16_t* XC; const float* b_a; const float* b_x; const float* lam;
    __device__ __forceinline__ void operator()(const f32x4 (&acc)[2][2][4][2], const Unit& u, int wr, int wc, int fr, int fq, const float (&rs)[2][4]) const {
        asm volatile("" : "+v"(fr), "+v"(fq));
        const int row0 = u.pm * BM + wr * 64 + fr; const int dir = u.pn >> 2, cbase = (u.pn & 3) * HALF + wc * 32 + 8 * fq;
        float ba[8], bx[8], sp[8];
#pragma unroll
        for (int j = 0; j < 8; ++j) { ba[j] = b_a[dir * 512 + cbase + j]; bx[j] = b_x[dir * 512 + cbase + j];
            const float e = __expf(-lam[dir * 512 + cbase + j]);
            sp[j] = 8.0f * LOG2E * (e < 0.02f ? e * (1.0f - e * (0.5f - e * (0.33333333f - 0.25f * e))) : __logf(1.0f + e)); }
#pragma unroll
        for (int ai = 0; ai < 2; ++ai)
#pragma unroll
            for (int m = 0; m < 4; ++m) { const int row = row0 + ai * HALF + m * 16;
                const u32x4 xw = *(const u32x4*)(XC + (size_t)row * 512 + cbase);
                float xc[8] = {bf_lo(xw.x), bf_hi(xw.x), bf_lo(xw.y), bf_hi(xw.y), bf_lo(xw.z), bf_hi(xw.z), bf_lo(xw.w), bf_hi(xw.w)};
                float la[8], uu[8];
#pragma unroll
                for (int j = 0; j < 8; ++j) { const float r = sigmoidf_(acc[ai][0][m][j >> 2][j & 3] + ba[j]), ig = sigmoidf_(acc[ai][1][m][j >> 2][j & 3] + bx[j]);
                    la[j] = -r * sp[j]; const float a2 = __builtin_amdgcn_exp2f(2.0f * la[j]); uu[j] = __builtin_sqrtf(fmaxf(1.0f - a2, 0.0f)) * ig * xc[j]; }
                u32x4 w; w.x = cvt_pk_bf16(la[0], la[1]); w.y = cvt_pk_bf16(la[2], la[3]); w.z = cvt_pk_bf16(la[4], la[5]); w.w = cvt_pk_bf16(la[6], la[7]);
                *(u32x4*)(LA + (size_t)row * 1024 + dir * 512 + cbase) = w;
                w.x = cvt_pk_bf16(uu[0], uu[1]); w.y = cvt_pk_bf16(uu[2], uu[3]); w.z = cvt_pk_bf16(uu[4], uu[5]); w.w = cvt_pk_bf16(uu[6], uu[7]);
                *(u32x4*)(U + (size_t)row * 1024 + dir * 512 + cbase) = w; }
    }
};
}

template <class Epi, bool ALIGN>
__device__ __forceinline__ void run_gemm(LAS unsigned char* lds, const bf16_t* A, int lda, const bf16_t* Bt, int N, int K, const Epi E, int cidx, int kslice = 0) {
    pg8::Gemm g{A, Bt, lda, T, N, K, kslice}; pg8::StaticOrder S; S.init(T, N, (int)gridDim.x, cidx);
    pg8::gemm_phase<Epi, ALIGN>(lds, g, S, E);
}

namespace att {
typedef LAS const char* lds_cptr;
typedef short v4i16_t __attribute__((ext_vector_type(4)));
constexpr int KSLOT = 12288, VSLOT = 8192;
constexpr int LDS_K = 0, LDS_V = 2 * KSLOT, LDS_WS = LDS_V + 3 * VSLOT, LDS_OST = LDS_WS + 8 * 256, LDS_END = LDS_OST + 8 * 4096;
__device__ __forceinline__ int crow(int r, int hi) { return (r & 3) + 8 * (r >> 2) + 4 * hi; }
__device__ __forceinline__ void glds16(const void* gsrc, unsigned lds_dst) { unsigned keep;
    asm volatile("s_mov_b32 %0, m0\n\ts_mov_b32 m0, %2\n\ts_nop 0\n\tglobal_load_lds_dwordx4 %1, off\n\ts_mov_b32 m0, %0" : "=&s"(keep) : "v"(gsrc), "s"(lds_dst) : "memory"); }
__device__ __forceinline__ s16x4 vtr(lds_cptr p) { return __builtin_bit_cast(s16x4, __builtin_amdgcn_ds_read_tr16_b64_v4i16((LAS v4i16_t*)p)); }
__device__ __forceinline__ float halfmax(float m) { auto rr = __builtin_amdgcn_permlane32_swap(__float_as_uint(m), __float_as_uint(m), false, false); return fmaxf(__uint_as_float(rr[0]), __uint_as_float(rr[1])); }
__device__ __forceinline__ float halfsum(float m) { auto rr = __builtin_amdgcn_permlane32_swap(__float_as_uint(m), __float_as_uint(m), false, false); return __uint_as_float(rr[0]) + __uint_as_float(rr[1]); }

struct Unit { const bf16_t* Q; int ldq; const bf16_t* K; int ldk; const bf16_t* KPE; const bf16_t* V; int ldv; bf16_t* O; int ldo; int t_lo, t_hi, qpos0; float slope2, sink2; };

template <int MODE> __device__ __forceinline__ void attn_unit(const Unit& a, char* shm) {
    constexpr int ND = MODE == 0 ? 6 : 4;
    constexpr float THR = 8.0f;
    int tid = threadIdx.x; asm volatile("" : "+v"(tid));
    const int lane = tid & 63, r32 = lane & 31, hi = lane >> 5; const int wid = __builtin_amdgcn_readfirstlane(tid >> 6);
    const unsigned lds0 = (unsigned)(uintptr_t)shm; const lds_cptr shm3 = (lds_cptr)shm;
    LAS float* wsf = (LAS float*)(shm3 + LDS_WS) + wid * 64;
    const bf16_t* ksrc = a.K + (long)lane * a.ldk + wid * 8;
    const bf16_t* kpsrc = a.KPE + (long)lane * 32 + (wid & 3) * 8;
    const bf16_t* vsrc = a.V + (long)(16 * (wid & 3) + (lane >> 2)) * a.ldv + (wid >> 2) * 32 + (lane & 3) * 8;
    const unsigned kdst = lds0 + LDS_K + wid * 1024, kpdst = lds0 + LDS_K + (8 + (wid & 3)) * 1024, vdst = lds0 + LDS_V + wid * 1024;
#define ATT_DMA(t, sk, sv) do { glds16(ksrc + (long)(t) * 64 * a.ldk, (unsigned)__builtin_amdgcn_readfirstlane(kdst + (sk) * KSLOT)); \
        if (MODE == 0 && wid < 4) glds16(kpsrc + (long)(t) * 64 * 32, (unsigned)__builtin_amdgcn_readfirstlane(kpdst + (sk) * KSLOT)); \
        glds16(vsrc + (long)(t) * 64 * a.ldv, (unsigned)__builtin_amdgcn_readfirstlane(vdst + (sv) * VSLOT)); } while (0)
#define ATT_WAIT_BAR() asm volatile("s_waitcnt vmcnt(0) lgkmcnt(0)\n\ts_barrier" ::: "memory")
#define ATT_PV(PW, vslot) do { const lds_cptr vp_ = vp0 + (vslot) * VSLOT; \
        _Pragma("unroll") for (int d0 = 0; d0 < 2; ++d0) _Pragma("unroll") for (int ks = 0; ks < 4; ++ks) { \
            const s16x4 lo_ = vtr(vp_ + d0 * 4096 + ks * 1024), hh_ = vtr(vp_ + d0 * 4096 + ks * 1024 + 512); \
            const bf16x8 vf_ = (bf16x8){lo_[0], lo_[1], lo_[2], lo_[3], hh_[0], hh_[1], hh_[2], hh_[3]}; \
            o[d0] = __builtin_amdgcn_mfma_f32_32x32x16_bf16(__builtin_bit_cast(bf16x8, (PW)[ks]), vf_, o[d0], 0, 0, 0); } } while (0)
    const int g = wid >> 2;
    ATT_DMA(a.t_lo, 0, 0);
    bf16x8 qr[ND];
    { const bf16_t* Qw = a.Q + (long)(wid * 32 + r32) * a.ldq + hi * 8;
#pragma unroll
      for (int d0 = 0; d0 < ND; ++d0) qr[d0] = *(const bf16x8*)(Qw + d0 * 16); }
    float mhat = (MODE == 1) ? a.sink2 : 0.f;
    float l_reg = (MODE == 1 && hi == 0) ? 1.f : 0.f;
    f32x16 o[2]; o[0] = f32x16{}; o[1] = f32x16{};
    f32x16 negm;
#pragma unroll
    for (int r = 0; r < 16; ++r) negm[r] = -mhat;
    const int tq0 = a.qpos0 + wid * 32, tq = tq0 + r32;
    const lds_cptr vp0 = shm3 + LDS_V + ((lane >> 4) & 1) * 32 + (lane & 3) * 8 + (4 * hi + ((lane & 15) >> 2)) * 64;
    u32x4 pw[4]; pw[0] = (u32x4){0u, 0u, 0u, 0u}; pw[1] = pw[0]; pw[2] = pw[0]; pw[3] = pw[0];
    bool pend = false; int sv = 0, svp = 0;
    for (int t = a.t_lo; t < a.t_hi; ++t) {
        const int s = (t - a.t_lo) & 1;
        ATT_WAIT_BAR();
        if (t + 1 < a.t_hi) ATT_DMA(t + 1, s ^ 1, (sv == 2 ? 0 : sv + 1));
        if (pend) { ATT_PV(pw, svp); pend = false; }
        bool active = true;
        if (MODE == 1) active = (64 * t + 63 >= tq0 - 128) && (64 * t <= tq0 + 31 + 128);
        if (active) {
            const lds_cptr kp = shm3 + LDS_K + s * KSLOT + hi * 1024 + r32 * 16;
            f32x16 p0 = negm, p1 = negm;
#pragma unroll
            for (int d0 = 0; d0 < ND; ++d0) {
                const bf16x8 b0 = *(const LAS bf16x8*)(kp + d0 * 2048), b1 = *(const LAS bf16x8*)(kp + d0 * 2048 + 512);
                p0 = __builtin_amdgcn_mfma_f32_32x32x16_bf16(b0, qr[d0], p0, 0, 0, 0);
                p1 = __builtin_amdgcn_mfma_f32_32x32x16_bf16(b1, qr[d0], p1, 0, 0, 0);
            }
            if (MODE == 1) {
#pragma unroll
                for (int r = 0; r < 16; ++r) { const int ks = 64 * t + crow(r, hi); const int r0 = abs(tq - ks), r1 = abs(tq - ks - 32);
                    p0[r] = (r0 <= 128) ? p0[r] - a.slope2 * (float)r0 : -INFINITY; p1[r] = (r1 <= 128) ? p1[r] - a.slope2 * (float)r1 : -INFINITY; }
            }
            float rm = fmaxf(p0[0], p1[0]);
#pragma unroll
            for (int r = 1; r < 16; ++r) rm = fmaxf(rm, fmaxf(p0[r], p1[r]));
            rm = halfmax(rm);
            const bool first = (MODE == 0) && (t == a.t_lo);
            if (first || __any(rm > THR)) {
                const float dl = first ? rm : fmaxf(rm, 0.f);
                mhat += dl;
#pragma unroll
                for (int r = 0; r < 16; ++r) { p0[r] -= dl; p1[r] -= dl; negm[r] = -mhat; }
                if (!first) {
                    const float f = __builtin_amdgcn_exp2f(-dl); l_reg *= f;
                    if (hi == 0) wsf[r32] = f;
#pragma unroll
                    for (int r = 0; r < 16; ++r) { const float fr_ = wsf[crow(r, hi)]; o[0][r] *= fr_; o[1][r] *= fr_; }
                }
            }
            float sacc = 0.f;
#pragma unroll
            for (int r = 0; r < 16; ++r) { p0[r] = __builtin_amdgcn_exp2f(p0[r]); p1[r] = __builtin_amdgcn_exp2f(p1[r]); sacc += p0[r] + p1[r]; }
            l_reg += sacc;
#pragma unroll
            for (int kk = 0; kk < 4; ++kk) { pw[0][kk] = cvt_pk_bf16(p0[2 * kk], p0[2 * kk + 1]); pw[1][kk] = cvt_pk_bf16(p0[8 + 2 * kk], p0[8 + 2 * kk + 1]);
                pw[2][kk] = cvt_pk_bf16(p1[2 * kk], p1[2 * kk + 1]); pw[3][kk] = cvt_pk_bf16(p1[8 + 2 * kk], p1[8 + 2 * kk + 1]); }
            if (g == 0) ATT_PV(pw, sv); else pend = true;
        }
        svp = sv; sv = (sv == 2) ? 0 : sv + 1;
    }
    if (pend) ATT_PV(pw, svp);
    l_reg = halfsum(l_reg);
    if (hi == 0) wsf[32 + r32] = l_reg;
    float rli[16];
#pragma unroll
    for (int r = 0; r < 16; ++r) rli[r] = __builtin_amdgcn_rcpf(wsf[32 + crow(r, hi)]);
    { LAS bf16_t* stg = (LAS bf16_t*)(shm3 + LDS_OST) + wid * 2048;
#pragma unroll
      for (int r = 0; r < 16; ++r) { const int orow = crow(r, hi);
#pragma unroll
          for (int d0 = 0; d0 < 2; ++d0) stg[orow * 64 + d0 * 32 + r32] = (bf16_t)(cvt_pk_bf16(o[d0][r] * rli[r], 0.f) & 0xffffu); }
      bf16_t* Ow = a.O + (long)(wid * 32) * a.ldo;
#pragma unroll
      for (int i = 0; i < 4; ++i) { const int row = i * 8 + (lane >> 3), ch = lane & 7; const u32x4 v = *(const LAS u32x4*)(stg + row * 64 + ch * 8); *(u32x4*)(Ow + (long)row * a.ldo + ch * 8) = v; } }
    asm volatile("s_waitcnt lgkmcnt(0)\n\ts_barrier" ::: "memory");
#undef ATT_DMA
#undef ATT_WAIT_BAR
#undef ATT_PV
}
}


#define XB_TMO      128
#define XB_XCNT(j)  (256  + 64 * (j))
#define XB_XSUB(j)  (1280 + 64 * (j))
#define XB_XGEN(j)  (2304 + 64 * (j))
#define XB_TOP      3328
#define XB_TOPGEN   3392
#define XCD_BAR_WORDS 3456
#define XL_CNT(j)   (3584 + 64 * (j))
#define XB_SPIN_CAP (1u << 22)
__device__ __forceinline__ unsigned xb_ld(unsigned* p)              { return __hip_atomic_load(p, __ATOMIC_RELAXED, __HIP_MEMORY_SCOPE_AGENT); }
__device__ __forceinline__ unsigned xb_add(unsigned* p, unsigned v) { return __hip_atomic_fetch_add(p, v, __ATOMIC_RELAXED, __HIP_MEMORY_SCOPE_AGENT); }
__device__ __forceinline__ unsigned xb_xcc_id() { return (unsigned)__builtin_amdgcn_s_getreg((3 << 11) | 20) & 0xFu; }
#define XB_SPIN(cond, bar) do { unsigned _sp = 0; while (cond) { __builtin_amdgcn_s_sleep(1); \
    if ((++_sp & 255u) == 0u) { if (xb_ld(&(bar)[XB_TMO])) break; if (_sp > XB_SPIN_CAP) { atomicAdd(&(bar)[XB_TMO], 1u); break; } } } } while (0)
struct XcdBarrier { unsigned* bar; unsigned x; volatile LAS unsigned* st; };
__device__ __forceinline__ XcdBarrier xcd_barrier_post(unsigned* bar, volatile LAS unsigned* st) {
    XcdBarrier b; b.bar = bar; b.x = xb_xcc_id(); b.st = st;
    if (threadIdx.x == 0) (void)xb_add(&bar[XB_XCNT(b.x)], 1u);
    return b;
}
__device__ __forceinline__ void xcd_barrier_complete(unsigned* bar, unsigned x, unsigned& nloc, unsigned& nx) {
    const unsigned G = gridDim.x * gridDim.y * gridDim.z;
    unsigned sum, cnt, mine, sp = 0u;
    for (;;) {
        sum = 0u; cnt = 0u; mine = 0u;
#pragma unroll
        for (unsigned j = 0; j < 16; ++j) { const unsigned c = xb_ld(&bar[XB_XCNT(j)]); sum += c; cnt += (c > 0u) ? 1u : 0u; mine = (j == x) ? c : mine; }
        if (sum == G) break;
        __builtin_amdgcn_s_sleep(1);
        if ((++sp & 255u) == 0u) { if (xb_ld(&bar[XB_TMO])) break; if (sp > XB_SPIN_CAP) { atomicAdd(&bar[XB_TMO], 1u); break; } }
    }
    nloc = mine > 0u ? mine : 1u; nx = cnt > 0u ? cnt : 1u;
}
__device__ __forceinline__ void xcd_barrier(const XcdBarrier& b) {
    asm volatile("s_waitcnt vmcnt(0)" ::: "memory");
    __syncthreads();
    if (threadIdx.x == 0) {
        unsigned* bar = b.bar;
        __builtin_amdgcn_s_waitcnt(0);
        unsigned nloc = b.st[0], nx = b.st[1];
        if (nloc == 0u) { xcd_barrier_complete(bar, b.x, nloc, nx); b.st[0] = nloc; b.st[1] = nx; }
        const unsigned old = xb_add(&bar[XB_XSUB(b.x)], 1u);
        const unsigned gen = old / nloc;
        if (old + 1u == (gen + 1u) * nloc) {
            __builtin_amdgcn_fence(__ATOMIC_RELEASE, "agent");
            asm volatile("s_waitcnt vmcnt(0)" ::: "memory");
            const unsigned og = xb_add(&bar[XB_TOP], 1u);
            const unsigned tg = og / nx;
            if (og + 1u == (tg + 1u) * nx) xb_add(&bar[XB_TOPGEN], 1u);
            else XB_SPIN(xb_ld(&bar[XB_TOPGEN]) == tg, bar);
            __builtin_amdgcn_fence(__ATOMIC_ACQUIRE, "agent");
            xb_add(&bar[XB_XGEN(b.x)], 1u);
            asm volatile("s_waitcnt vmcnt(0)" ::: "memory");
        } else {
            XB_SPIN(xb_ld(&bar[XB_XGEN(b.x)]) == gen, bar);
            __builtin_amdgcn_fence(__ATOMIC_ACQUIRE, "agent");
            asm volatile("s_waitcnt vmcnt(0)" ::: "memory");
        }
    }
    __syncthreads();
}

__device__ __forceinline__ void xcd_local_barrier(const XcdBarrier& b, unsigned nloc) {
    asm volatile("s_waitcnt vmcnt(0)" ::: "memory");
    __syncthreads();
    if (threadIdx.x == 0) {
        unsigned* bar = b.bar;
        __builtin_amdgcn_s_waitcnt(0);
        const unsigned lgen = b.st[5] + 1u; b.st[5] = lgen;
        (void)xb_add(&bar[XL_CNT(b.x)], 1u);
        const unsigned target = lgen * nloc;
        XB_SPIN(xb_ld(&bar[XL_CNT(b.x)]) < target, bar);
        __builtin_amdgcn_fence(__ATOMIC_ACQUIRE, "agent");
        asm volatile("s_waitcnt vmcnt(0)" ::: "memory");
    }
    __syncthreads();
}

struct Params { const float* in[25]; float* out; unsigned char* ws; int ph_lo, ph_hi; };
enum { I_XP = 0, I_XS, I_FFN_NORM, I_FFN_G, I_FFN_U, I_FFN_D, I_MIX_NORM, I_EV_IN, I_EV_CONV, I_Q_NORM, I_W_UQ, I_KV_NORM, I_W_UKV, I_EV_OUT,
       I_OD_IN, I_OD_CONV, I_OD_CONVB, I_LRU_WA, I_LRU_BA, I_LRU_WX, I_LRU_BX, I_LRU_LAM, I_SINK, I_OD_OUT, I_FINAL_NORM };

__device__ __forceinline__ int rope_perm(int j) { return j < 16 ? 2 * j : 2 * (j - 16) + 1; }

struct PrepJob { const float* W; const float* gain; bf16_t* WT; float scale; int N, K, mode, kb, nb; };
__device__ __forceinline__ void prep_load(const PrepJob& j, int lane, f32x4 (&v)[16]) {
    const int k0 = 64 * j.kb, n0 = 64 * j.nb, cq = (lane & 15) * 4, rq = lane >> 4;
    const bool colok = (n0 + cq) < j.N;
#pragma unroll
    for (int i = 0; i < 16; ++i) v[i] = colok ? *(const f32x4*)(j.W + (size_t)(k0 + 4 * i + rq) * j.N + n0 + cq) : (f32x4){0.f, 0.f, 0.f, 0.f};
}
__device__ __forceinline__ void prep_store(const PrepJob& j, int lane, const f32x4 (&v)[16], LAS float* scr) {
    const int k0 = 64 * j.kb, n0 = 64 * j.nb, cq = (lane & 15) * 4, rq = lane >> 4, mode = j.mode;
#pragma unroll
    for (int i = 0; i < 16; ++i) { LAS float* d = scr + (4 * i + rq) * 65 + cq; d[0] = v[i].x; d[1] = v[i].y; d[2] = v[i].z; d[3] = v[i].w; }
    asm volatile("s_waitcnt lgkmcnt(0)" ::: "memory");
    const int c = lane & 7;
    float g[8];
#pragma unroll
    for (int e = 0; e < 8; ++e) g[e] = (j.gain ? j.gain[k0 + 8 * c + e] : 1.0f) * j.scale;
#pragma unroll
    for (int jj = 0; jj < 8; ++jj) { const int n = (lane >> 3) + 8 * jj; const LAS float* sp = scr + (8 * c) * 65 + n;
        u32x4 o; o.x = cvt_pk_bf16(sp[0 * 65] * g[0], sp[1 * 65] * g[1]); o.y = cvt_pk_bf16(sp[2 * 65] * g[2], sp[3 * 65] * g[3]); o.z = cvt_pk_bf16(sp[4 * 65] * g[4], sp[5 * 65] * g[5]); o.w = cvt_pk_bf16(sp[6 * 65] * g[6], sp[7 * 65] * g[7]);
        const int ns = n0 + n; int row;
        if (mode == 0) row = ns;
        else if (mode == 1) row = (ns >> 7) * 256 + (ns & 127);
        else if (mode == 2) row = (ns >> 7) * 256 + 128 + (ns & 127);
        else if (mode == 3) { const int h = ns / 96, d = ns % 96; row = h * 96 + (d < 64 ? d : 64 + rope_perm(d - 64)); }
        else if (mode == 4) row = ns < 2176 ? ns : 2176 + rope_perm(ns - 2176);
        else row = ns < 512 ? ns : (ns < 1024 ? ns + 512 : (ns < 1536 ? ns - 512 : ns));
        if (ns < j.N) *(u32x4*)(j.WT + (size_t)row * j.K + k0 + 8 * c) = o; }
    asm volatile("s_waitcnt lgkmcnt(0)" ::: "memory");
}

__device__ __forceinline__ void norm_row(const float* xrow, bf16_t* orow, float* prow, int lane) {
    const f32x4* xr = (const f32x4*)xrow + lane;
    f32x4 v[4]; float s = 0.f;
#pragma unroll
    for (int j = 0; j < 4; ++j) { v[j] = xr[64 * j]; s += (v[j].x * v[j].x + v[j].y * v[j].y) + (v[j].z * v[j].z + v[j].w * v[j].w); }
    const float tot = wave_sum(s);
    if (lane < 16) prow[lane] = lane == 0 ? tot : 0.f;
    u32x2* o8 = (u32x2*)orow + lane;
#pragma unroll
    for (int j = 0; j < 4; ++j) { u32x2 w; w.x = cvt_pk_bf16(v[j].x, v[j].y); w.y = cvt_pk_bf16(v[j].z, v[j].w); o8[64 * j] = w; }
}
__device__ __forceinline__ void norm_phase(const float* src0, const float* src1, bf16_t* XN, float* part, int gw, int NGW, int lane) {
    for (int m = gw; m < T; m += NGW) norm_row(m < TP ? src0 + (size_t)m * DM : src1 + (size_t)(m - TP) * DM, XN + (size_t)m * DM, part + (size_t)m * 16, lane);
}
__device__ __forceinline__ float gelu_tanh(float x) { const float u = 0.7978845608028654f * (x + 0.044715f * x * x * x); const float e = __builtin_amdgcn_exp2f(2.0f * LOG2E * u); const float th = 1.0f - 2.0f * __builtin_amdgcn_rcpf(e + 1.0f); return 0.5f * x * (1.0f + th); }
__device__ __forceinline__ void unpack8(const u32x4 w, float (&f)[8]) { f[0] = bf_lo(w.x); f[1] = bf_hi(w.x); f[2] = bf_lo(w.y); f[3] = bf_hi(w.y); f[4] = bf_lo(w.z); f[5] = bf_hi(w.z); f[6] = bf_lo(w.w); f[7] = bf_hi(w.w); }
__device__ __forceinline__ u32x4 pack8(const float (&f)[8]) { u32x4 w; w.x = cvt_pk_bf16(f[0], f[1]); w.y = cvt_pk_bf16(f[2], f[3]); w.z = cvt_pk_bf16(f[4], f[5]); w.w = cvt_pk_bf16(f[6], f[7]); return w; }

__global__ void __launch_bounds__(NTHREADS) mk_fwd(Params P) {
    extern __shared__ __attribute__((aligned(16))) unsigned char lds_raw[];
    LAS unsigned char* lds = (LAS unsigned char*)lds_raw;
    cg::grid_group grid = cg::this_grid();
    const int G = gridDim.x, bx = blockIdx.x;
    const int NGW = G * 8, NGT = G * NTHREADS;
    unsigned char* ws = P.ws;
    float* out = P.out;
    bf16_t* Wb = (bf16_t*)(ws + WS_W);
    bf16_t* XN = (bf16_t*)(ws + WS_XN);
    unsigned char* big = ws + WS_BIG;
    float* rope_tab = (float*)(ws + WS_ROPE);
    float* aggP = (float*)(ws + WS_AGG); float* aggH = aggP + 512 * 1024; float* aggC = aggH + 512 * 1024;
    float* part = aggP;
    const int lo = P.ph_lo, hi = P.ph_hi;
    int ph = 0;
    volatile LAS unsigned* bst = (volatile LAS unsigned*)(lds + LDS_BYTES - 64);
    if (threadIdx.x < 8) bst[threadIdx.x] = 0u;
    __syncthreads();
    XcdBarrier xbar; xbar.bar = (unsigned*)(ws + WS_BAR); xbar.x = xb_xcc_id(); xbar.st = bst;
    if (threadIdx.x == 0) { bst[4] = xb_add(&xbar.bar[XB_XCNT(xbar.x)], 1u);
        bst[2] = (unsigned)bx; bst[3] = (unsigned)((G % 8 == 0) ? (bx % 8) * (G / 8) + bx / 8 : bx); }
    __syncthreads();
#define BEGIN_PH if (ph >= lo && ph < hi) { int tid = threadIdx.x; asm volatile("" : "+v"(tid)); const int lane = tid & 63, wave = __builtin_amdgcn_readfirstlane(tid >> 6); \
        const int cidx = __builtin_amdgcn_readfirstlane((int)bst[2]); const unsigned pw_ = (unsigned)__builtin_amdgcn_readfirstlane((int)bst[3]); const int vcu = (int)(pw_ & 0xffffu); const bool xl_ok = (pw_ >> 16) != 0u; \
        const int gw = vcu * 8 + wave, gt = bx * NTHREADS + tid; (void)lane; (void)gw; (void)gt; (void)cidx; (void)xl_ok;
#define END_PH_X(loc_) if (ph + 1 < hi) { if (ph == 0) grid.sync(); else if (xl_ok && (loc_)) xcd_local_barrier(xbar, (unsigned)(G / 8)); else xcd_barrier(xbar); } } ++ph;
#define END_PH   END_PH_X(false)

    BEGIN_PH
    {
        LAS float* scr = (LAS float*)(lds + wave * 16640);
        constexpr int N_FFN = 24 * 704, N_EV = 2 * 952, N_OD = 2 * 704, N_ALL = N_FFN + N_EV + N_OD;
#define PREP_DECODE(it_, J_) do { const int it = (it_); \
            const float* W; int K, N, mode; const float* gain = nullptr; float scale = 1.f; bf16_t* WT; int r; \
            if (it < N_FFN) { const int j = it / 704; r = it % 704; const int f = j / 3, w = j % 3; \
                if (w < 2) { W = P.in[w == 0 ? I_FFN_G : I_FFN_U] + (size_t)f * DM * FF; K = DM; N = FF; gain = P.in[I_FFN_NORM] + f * DM; mode = 1 + w; WT = Wb + W_GU + f * W_GU_SZ; } \
                else { W = P.in[I_FFN_D] + (size_t)f * FF * DM; K = FF; N = DM; mode = 0; WT = Wb + W_DN + f * W_DN_SZ; } } \
            else if (it < N_FFN + N_EV) { const int i2 = it - N_FFN; const int jj = i2 / 952; r = i2 % 952; \
                if (r < 560) { W = P.in[I_EV_IN] + (size_t)jj * DM * EV_IN; K = DM; N = EV_IN; gain = P.in[I_MIX_NORM] + (2 * jj) * DM; mode = 4; WT = Wb + W_EVIN + jj * W_EVIN_SZ; } \
                else if (r < 632) { r -= 560; W = P.in[I_W_UQ] + (size_t)jj * 384 * 768; K = 384; N = 768; gain = P.in[I_Q_NORM] + jj * 384; mode = 3; scale = 0.10206207261596575f * LOG2E; WT = Wb + W_UQ + jj * W_UQ_SZ; } \
                else if (r < 696) { r -= 632; W = P.in[I_W_UKV] + (size_t)jj * 256 * 1024; K = 256; N = 1024; gain = P.in[I_KV_NORM] + jj * 256; mode = 0; WT = Wb + W_UKV + jj * W_UKV_SZ; } \
                else { r -= 696; W = P.in[I_EV_OUT] + (size_t)jj * DM * DM; K = DM; N = DM; mode = 0; WT = Wb + W_EVOUT + jj * W_SQ_SZ; } } \
            else { const int i2 = it - N_FFN - N_EV; const int jj = i2 / 704; r = i2 % 704; \
                if (r < 448) { W = P.in[I_OD_IN] + (size_t)jj * DM * OD_IN; K = DM; N = OD_IN; gain = P.in[I_MIX_NORM] + (2 * jj + 1) * DM; mode = 5; WT = Wb + W_ODIN + jj * W_ODIN_SZ; } \
                else { r -= 448; W = P.in[I_OD_OUT] + (size_t)jj * DM * DM; K = DM; N = DM; mode = 0; WT = Wb + W_ODOUT + jj * W_SQ_SZ; } } \
            const int nblk = (N + 63) / 64, kb = r / nblk, nb = r % nblk; \
            if (mode == 5 && nb >= 16 && nb < 24) scale = 0.125f * LOG2E;     \
            (J_) = PrepJob{W, gain, WT, scale, N, K, mode, kb, nb}; } while (0)
        for (int it0 = gw; it0 < N_ALL; it0 += 2 * NGW) {
            PrepJob ja, jb; f32x4 va[16], vb[16]; const bool hb = it0 + NGW < N_ALL;
            PREP_DECODE(it0, ja); prep_load(ja, lane, va);
            if (hb) { PREP_DECODE(it0 + NGW, jb); prep_load(jb, lane, vb); }
            prep_store(ja, lane, va, scr);
            if (hb) prep_store(jb, lane, vb, scr);
        }
#undef PREP_DECODE
        for (int i = gt; i < 2 * 96 * 1024 / 8; i += NGT) { const int jj = i / (96 * 128), rr = i % (96 * 128); *(u32x4*)(Wb + W_EVIN + jj * W_EVIN_SZ + (size_t)EV_IN * 1024 + (size_t)rr * 8) = (u32x4){0u, 0u, 0u, 0u}; }
        for (int i = gt; i < 2 * 2048 * 64; i += NGT) { const int jj = i / (2048 * 64), rr = (i / 64) % 2048, cc = (i % 64) * 8;
            const int unit = rr >> 8, gate = (rr >> 7) & 1, c = (unit & 3) * 128 + (rr & 127), dir = unit >> 2, nb = c >> 6, d = c & 63;
            u32x4 w = (u32x4){0u, 0u, 0u, 0u};
            if ((cc >> 6) == nb) { const float* src = P.in[gate ? I_LRU_WX : I_LRU_WA] + ((((size_t)jj * 2 + dir) * 8 + nb) * 64 + (cc & 63)) * 64 + d; float f[8];
#pragma unroll
                for (int j = 0; j < 8; ++j) f[j] = src[j * 64];
                w = pack8(f); }
            *(u32x4*)(Wb + W_LRU + jj * W_LRU_SZ + (size_t)rr * 512 + cc) = w; }
        for (int i = gt; i < 8192 * 16; i += NGT) { const int pos = i >> 4, fi = i & 15;
            const double inv = exp2(-(double)fi * (13.287712379549449 / 16.0));
            const double rev = (double)pos * inv * 0.15915494309189535; const float fr = (float)(rev - rint(rev));
            rope_tab[2 * i] = __builtin_amdgcn_cosf(fr); rope_tab[2 * i + 1] = __builtin_amdgcn_sinf(fr); }
        norm_phase(P.in[I_XP], P.in[I_XS], XN, part, gw, NGW, lane);
    }
    END_PH
    if (hi - lo > 1 && (G % 8) == 0) {
        bool ok = true;
#pragma unroll
        for (unsigned j = 0; j < 16; ++j) { const unsigned c = xb_ld(&xbar.bar[XB_XCNT(j)]); ok = ok && (c == (j < 8 ? (unsigned)(G / 8) : 0u)); }
        if (__builtin_amdgcn_readfirstlane((int)ok) != 0) {
            if (threadIdx.x == 0) { const unsigned rk = bst[4]; bst[2] = rk * 8u + xbar.x; bst[3] = (xbar.x * (unsigned)(G / 8) + rk) | (1u << 16); }
            __syncthreads();
        }
    }

#pragma unroll 1
    for (int l = 0; l < 4; ++l) {
        const int jj = l >> 1;
#pragma unroll 1
        for (int sub = 0; sub < 3; ++sub) {
            if (sub != 1) {
                const int f = l * 2 + (sub >> 1);
                BEGIN_PH { pg8::EpiSwiglu E{(bf16_t*)(big + B_ACT), part}; run_gemm<pg8::EpiSwiglu, true>(lds, XN, DM, Wb + W_GU + f * W_GU_SZ, 5632, DM, E, cidx); } END_PH_X(true)
                BEGIN_PH { pg8::EpiRes E{XN, part, 0.5f};
                    run_gemm<pg8::EpiRes, true>(lds, (const bf16_t*)(big + B_ACT), FF, Wb + W_DN + f * W_DN_SZ, DM, FF, E, cidx); } END_PH_X(sub == 0 || l < 3)
            } else if ((l & 1) == 0) {
                bf16_t* Z = (bf16_t*)(big + B_Z); bf16_t* Q = (bf16_t*)((unsigned char*)out + O_Q); bf16_t* KPE = (bf16_t*)((unsigned char*)out + O_KPE); bf16_t* KV = (bf16_t*)out;
                BEGIN_PH { pg8::EpiStore<true> E{Z, ZLD, part}; run_gemm<pg8::EpiStore<true>, true>(lds, XN, DM, Wb + W_EVIN + jj * W_EVIN_SZ, EV_INP, DM, E, cidx); } END_PH
                BEGIN_PH {
                    const float* cw = P.in[I_EV_CONV] + jj * 3 * 512;
                    float w0[8], w1[8], w2[8];
#pragma unroll
                    for (int j = 0; j < 8; ++j) { w0[j] = cw[lane * 8 + j]; w1[j] = cw[512 + lane * 8 + j]; w2[j] = cw[1024 + lane * 8 + j]; }
                    const int CH = (T + NGW - 1) / NGW; const int t0 = gw * CH, t1 = (t0 + CH < T) ? t0 + CH : T;
                    if (t0 < t1) {
                        float gp[8], gc[8], ta[8], tb[8];
                        { const bf16_t* zr = Z + (size_t)t0 * ZLD; unpack8(*(const u32x4*)(zr + 512 + lane * 8), ta); unpack8(*(const u32x4*)(zr + 1024 + lane * 8), tb);
#pragma unroll
                          for (int j = 0; j < 8; ++j) gc[j] = ta[j] * tb[j];
                          if (t0 > 0) { unpack8(*(const u32x4*)(zr - ZLD + 512 + lane * 8), ta); unpack8(*(const u32x4*)(zr - ZLD + 1024 + lane * 8), tb); }
#pragma unroll
                          for (int j = 0; j < 8; ++j) gp[j] = t0 > 0 ? ta[j] * tb[j] : 0.f; }
                        u32x4 rbg, rql, rkl, rcn, rxn; unsigned rkr;
#define EV_PREFETCH(t_) do { const bf16_t* z_ = Z + (size_t)(t_) * ZLD; rbg = *(const u32x4*)(z_ + lane * 8); rql = *(const u32x4*)(z_ + 1536 + (lane < 48 ? lane : 0) * 8); \
                            rkl = *(const u32x4*)(z_ + 1920 + (lane & 31) * 8); rkr = *(const unsigned*)(z_ + 2176 + (lane & 15) * 2); \
                            if ((t_) + 1 < T) { rcn = *(const u32x4*)(z_ + ZLD + 512 + lane * 8); rxn = *(const u32x4*)(z_ + ZLD + 1024 + lane * 8); } else { rcn = (u32x4){0u, 0u, 0u, 0u}; rxn = rcn; } } while (0)
                        EV_PREFETCH(t0);
                        for (int m = t0; m < t1; ++m) {
                            const int S = m < TP ? 8192 : 4096, pos = m & (S - 1);
                            bf16_t* zr = Z + (size_t)m * ZLD;
                            const u32x4 cbg = rbg, cql = rql, ckl = rkl, ccn = rcn, cxn = rxn; const unsigned krw = rkr;
                            if (m + 1 < t1) EV_PREFETCH(m + 1);
                            float bg[8], gn[8], acc8[8];
                            unpack8(cbg, bg); unpack8(ccn, ta); unpack8(cxn, tb);
#pragma unroll
                            for (int j = 0; j < 8; ++j) gn[j] = ta[j] * tb[j];
                            const float fp = pos > 0 ? 1.f : 0.f, fn = pos < S - 1 ? 1.f : 0.f;
#pragma unroll
                            for (int j = 0; j < 8; ++j) acc8[j] = bg[j] * (w1[j] * gc[j] + fp * w0[j] * gp[j] + fn * w2[j] * gn[j]);
                            float ql[8], kl[8]; float sq = 0.f, sk = 0.f;
                            unpack8(cql, ql); unpack8(ckl, kl);
#pragma unroll
                            for (int j = 0; j < 8; ++j) { sq += ql[j] * ql[j]; sk += kl[j] * kl[j]; }
                            if (lane >= 48) sq = 0.f;
                            if (lane >= 32) sk = 0.f;
                            sq = wave_sum(sq); sk = wave_sum(sk);
                            const float rq = rsqrtf(sq * (1.f / 384.f) + EPS), rk = rsqrtf(sk * (1.f / 256.f) + EPS);
                            *(u32x4*)(zr + lane * 8) = pack8(acc8);
                            if (lane < 48) {
#pragma unroll
                                for (int j = 0; j < 8; ++j) ql[j] *= rq;
                                *(u32x4*)(zr + 1536 + lane * 8) = pack8(ql); }
                            if (lane < 32) {
#pragma unroll
                                for (int j = 0; j < 8; ++j) kl[j] *= rk;
                                *(u32x4*)(zr + 1920 + lane * 8) = pack8(kl); }
                            if (lane < 16) { const float x1 = bf_lo(krw), x2 = bf_hi(krw); const f32x2 cs = *(const f32x2*)(rope_tab + ((size_t)pos * 16 + lane) * 2);
                                *(unsigned*)(KPE + (size_t)m * 32 + lane * 2) = cvt_pk_bf16(x1 * cs.x - x2 * cs.y, x1 * cs.y + x2 * cs.x); }
#pragma unroll
                            for (int j = 0; j < 8; ++j) { gp[j] = gc[j]; gc[j] = gn[j]; }
                        }
#undef EV_PREFETCH
                    }
                } END_PH_X(true)
                BEGIN_PH {
                    { pg8::EpiQRope E{Q, rope_tab}; run_gemm<pg8::EpiQRope, true>(lds, Z + 1536, ZLD, Wb + W_UQ + jj * W_UQ_SZ, 768, 384, E, cidx); }
                    { pg8::EpiStore<false> E{KV, 1024, nullptr}; run_gemm<pg8::EpiStore<false>, true>(lds, Z + 1920, ZLD, Wb + W_UKV + jj * W_UKV_SZ, 1024, 256, E, cidx); }
                } END_PH
                BEGIN_PH {
                    for (int u = vcu; u < 1024; u += G) {
                        int seq0, S, h, qb;
                        if (u < 512) { const int sh = u >> 5; qb = u & 31; seq0 = (sh >> 3) * 8192; S = 8192; h = sh & 7; }
                        else { const int u2 = u - 512, sh = u2 >> 4; qb = u2 & 15; seq0 = TP + (sh >> 3) * 4096; S = 4096; h = sh & 7; }
                        att::Unit a; const size_t r0 = (size_t)seq0 + qb * 256;
                        a.Q = Q + r0 * 768 + h * 96; a.ldq = 768; a.K = KV + (size_t)seq0 * 1024 + h * 128; a.ldk = 1024; a.KPE = KPE + (size_t)seq0 * 32;
                        a.V = KV + (size_t)seq0 * 1024 + h * 128 + 64; a.ldv = 1024; a.O = Z + r0 * ZLD + 512 + h * 64; a.ldo = ZLD;
                        a.t_lo = 0; a.t_hi = S / 64; a.qpos0 = qb * 256; a.slope2 = 0.f; a.sink2 = 0.f;
                        att::attn_unit<0>(a, (char*)lds_raw);
                    }
                } END_PH
                BEGIN_PH { pg8::EpiRes E{XN, part, 1.0f}; run_gemm<pg8::EpiRes, true>(lds, Z, ZLD, Wb + W_EVOUT + jj * W_SQ_SZ, DM, DM, E, cidx); } END_PH_X(true)
            } else {
                bf16_t* Z2 = (bf16_t*)(big + B_Z2); bf16_t* XC = (bf16_t*)(big + B_XC); bf16_t* U = (bf16_t*)((unsigned char*)out + O_U); bf16_t* LA = (bf16_t*)out;
                BEGIN_PH { pg8::EpiStore<true> E{Z2, ZLD, part}; run_gemm<pg8::EpiStore<true>, true>(lds, XN, DM, Wb + W_ODIN + jj * W_ODIN_SZ, OD_IN, DM, E, cidx); } END_PH
                BEGIN_PH {
                    const float* cw = P.in[I_OD_CONV] + jj * 4 * 512; const float* cb = P.in[I_OD_CONVB] + jj * 512;
                    float w4[4][8], bb[8];
#pragma unroll
                    for (int j = 0; j < 8; ++j) { bb[j] = cb[lane * 8 + j];
#pragma unroll
                        for (int k = 0; k < 4; ++k) w4[k][j] = cw[k * 512 + lane * 8 + j]; }
                    const int CH = (T + NGW - 1) / NGW; const int t0 = gw * CH, t1 = (t0 + CH < T) ? t0 + CH : T;
                    if (t0 < t1) {
                        const u32x4 zero4 = (u32x4){0u, 0u, 0u, 0u};
                        const bf16_t* z0 = Z2 + (size_t)t0 * ZLD + lane * 8;
                        u32x4 r0 = t0 >= 2 ? *(const u32x4*)(z0 - 2 * ZLD) : zero4, r1 = t0 >= 1 ? *(const u32x4*)(z0 - ZLD) : zero4, r2 = *(const u32x4*)z0;
                        u32x4 r3 = (t0 + 1 < T) ? *(const u32x4*)(z0 + ZLD) : zero4;
                        for (int m = t0; m < t1; ++m) {
                            const int S = m < TP ? 8192 : 4096, pos = m & (S - 1);
                            const u32x4 nx = (m + 2 < T) ? *(const u32x4*)(Z2 + (size_t)(m + 2) * ZLD + lane * 8) : zero4;
                            float x0[8], x1[8], x2[8], x3[8], a8[8];
                            unpack8(r0, x0); unpack8(r1, x1); unpack8(r2, x2); unpack8(r3, x3);
                            const float f0 = pos >= 2 ? 1.f : 0.f, f1 = pos >= 1 ? 1.f : 0.f, f3 = pos < S - 1 ? 1.f : 0.f;
#pragma unroll
                            for (int j = 0; j < 8; ++j) a8[j] = bb[j] + w4[2][j] * x2[j] + f0 * w4[0][j] * x0[j] + f1 * w4[1][j] * x1[j] + f3 * w4[3][j] * x3[j];
                            *(u32x4*)(XC + (size_t)m * 512 + lane * 8) = pack8(a8);
                            r0 = r1; r1 = r2; r2 = r3; r3 = nx;
                        }
                    }
                } END_PH_X(true)
                BEGIN_PH { pg8::EpiLru E{LA, U, XC, P.in[I_LRU_BA] + jj * 1024, P.in[I_LRU_BX] + jj * 1024, P.in[I_LRU_LAM] + jj * 1024};
                    run_gemm<pg8::EpiLru, true>(lds, XC, 512, Wb + W_LRU + jj * W_LRU_SZ, 2048, 512, E, cidx, 128); } END_PH
                BEGIN_PH {
                    for (int it = gt; it < 512 * 512; it += NGT) { const int ch = it >> 9, cp = it & 511, col = cp * 2; const bool bwd = col >= 512;
                        const size_t base = (size_t)ch * 64 * 1024 + col;
                        float h0 = 0.f, h1 = 0.f, s0 = 0.f, s1 = 0.f;
#pragma unroll 8
                        for (int i = 0; i < 64; ++i) { const int tt = bwd ? 63 - i : i; const unsigned lw = *(const unsigned*)(LA + base + (size_t)tt * 1024), uw = *(const unsigned*)(U + base + (size_t)tt * 1024);
                            const float l0 = bf_lo(lw), l1 = bf_hi(lw); s0 += l0; s1 += l1;
                            h0 = __builtin_amdgcn_exp2f(l0) * h0 + bf_lo(uw); h1 = __builtin_amdgcn_exp2f(l1) * h1 + bf_hi(uw); }
                        *(f32x2*)(aggP + (size_t)ch * 1024 + col) = (f32x2){__builtin_amdgcn_exp2f(s0), __builtin_amdgcn_exp2f(s1)};
                        *(f32x2*)(aggH + (size_t)ch * 1024 + col) = (f32x2){h0, h1}; }
                } END_PH
                BEGIN_PH {
                    for (int it = gt; it < 6 * 1024; it += NGT) { const int sq = it >> 10, col = it & 1023; const bool bwd = col >= 512;
                        const int c0 = sq < 2 ? sq * 128 : 256 + (sq - 2) * 64, nc = sq < 2 ? 128 : 64;
                        float c = 0.f;
                        for (int i0 = 0; i0 < nc; i0 += 8) { float p[8], hh[8];
#pragma unroll
                            for (int j = 0; j < 8; ++j) { const int ch = c0 + (bwd ? nc - 1 - (i0 + j) : i0 + j); p[j] = aggP[(size_t)ch * 1024 + col]; hh[j] = aggH[(size_t)ch * 1024 + col]; }
#pragma unroll
                            for (int j = 0; j < 8; ++j) { const int ch = c0 + (bwd ? nc - 1 - (i0 + j) : i0 + j); aggC[(size_t)ch * 1024 + col] = c; c = p[j] * c + hh[j]; } }
                    }
                } END_PH
                BEGIN_PH {
                    for (int it = gt; it < 512 * 256; it += NGT) { const int ch = it >> 8, cp = it & 255, col = cp * 2;
                        const size_t base = (size_t)ch * 64 * 1024 + col;
                        unsigned hfp[64];
                        { const f32x2 cf = *(const f32x2*)(aggC + (size_t)ch * 1024 + col); float h0 = cf.x, h1 = cf.y;
#pragma unroll
                          for (int b = 0; b < 8; ++b) { unsigned lw[8], uw[8];
#pragma unroll
                              for (int j = 0; j < 8; ++j) { const size_t ix = base + (size_t)(b * 8 + j) * 1024; lw[j] = *(const unsigned*)(LA + ix); uw[j] = *(const unsigned*)(U + ix); }
#pragma unroll
                              for (int j = 0; j < 8; ++j) { h0 = __builtin_amdgcn_exp2f(bf_lo(lw[j])) * h0 + bf_lo(uw[j]); h1 = __builtin_amdgcn_exp2f(bf_hi(lw[j])) * h1 + bf_hi(uw[j]); hfp[b * 8 + j] = cvt_pk_bf16(h0, h1); } } }
                        { const f32x2 cf = *(const f32x2*)(aggC + (size_t)ch * 1024 + 512 + col); float h0 = cf.x, h1 = cf.y;
#pragma unroll
                          for (int b = 7; b >= 0; --b) { unsigned lw[8], uw[8], gwd[8];
#pragma unroll
                              for (int j = 0; j < 8; ++j) { const size_t ix = base + (size_t)(b * 8 + j) * 1024 + 512; lw[j] = *(const unsigned*)(LA + ix); uw[j] = *(const unsigned*)(U + ix);
                                  gwd[j] = *(const unsigned*)(Z2 + (size_t)(ch * 64 + b * 8 + j) * ZLD + col + 1024); }
#pragma unroll
                              for (int j = 7; j >= 0; --j) { h0 = __builtin_amdgcn_exp2f(bf_lo(lw[j])) * h0 + bf_lo(uw[j]); h1 = __builtin_amdgcn_exp2f(bf_hi(lw[j])) * h1 + bf_hi(uw[j]);
                                  const unsigned hf = hfp[b * 8 + j];
                                  *(unsigned*)(Z2 + (size_t)(ch * 64 + b * 8 + j) * ZLD + col) = cvt_pk_bf16(gelu_tanh(bf_lo(gwd[j])) * (bf_lo(hf) + h0), gelu_tanh(bf_hi(gwd[j])) * (bf_hi(hf) + h1)); } } }
                    }
                    for (int u = vcu; u < 1024; u += G) { const int rb = u >> 3, h = u & 7; const size_t r0 = (size_t)rb * 256;
                        const int S = r0 < TP ? 8192 : 4096; const int qpos0 = (int)(r0 & (size_t)(S - 1)); const size_t seq0 = r0 - qpos0;
                        att::Unit a; a.Q = Z2 + r0 * ZLD + 512 + h * 64; a.ldq = ZLD; a.K = Z2 + seq0 * ZLD + 1536 + (h >> 2) * 64; a.ldk = ZLD; a.KPE = nullptr;
                        a.V = Z2 + seq0 * ZLD + 1664 + (h >> 2) * 64; a.ldv = ZLD; a.O = Z2 + r0 * ZLD + 512 + h * 64; a.ldo = ZLD;
                        a.t_lo = max(0, qpos0 / 64 - 2); a.t_hi = min(S / 64, qpos0 / 64 + 6); a.qpos0 = qpos0;
                        a.slope2 = exp2f(-(float)(h + 1)) * LOG2E; a.sink2 = P.in[I_SINK][jj * 8 + h] * LOG2E;
                        att::attn_unit<1>(a, (char*)lds_raw);
                    }
                } END_PH
                BEGIN_PH { pg8::EpiRes E{XN, part, 1.0f}; run_gemm<pg8::EpiRes, true>(lds, Z2, ZLD, Wb + W_ODOUT + jj * W_SQ_SZ, DM, DM, E, cidx); } END_PH_X(true)
            }
        }
    }
    BEGIN_PH {
        const float* gn = P.in[I_FINAL_NORM];
        f32x4 g4[4];
#pragma unroll
        for (int j = 0; j < 4; ++j) g4[j] = *((const f32x4*)gn + lane + 64 * j);
        for (int m = gw; m < T; m += NGW) { const u32x2* xr = (const u32x2*)(XN + (size_t)m * DM) + lane; f32x4 v[4]; float s = 0.f;
#pragma unroll
            for (int j = 0; j < 4; ++j) { const u32x2 w = xr[64 * j]; v[j] = (f32x4){bf_lo(w.x), bf_hi(w.x), bf_lo(w.y), bf_hi(w.y)}; s += (v[j].x * v[j].x + v[j].y * v[j].y) + (v[j].z * v[j].z + v[j].w * v[j].w); }
            const float rstd = rsqrtf(wave_sum(s) * (1.f / DM) + EPS);
            f32x4* orow = (f32x4*)(out + (size_t)m * DM) + lane;
#pragma unroll
            for (int j = 0; j < 4; ++j) orow[64 * j] = v[j] * rstd * g4[j]; }
    } END_PH
#undef BEGIN_PH
#undef END_PH
#undef END_PH_X
}

constexpr int N_PHASES = 1 + 4 * (2 + 2) + 2 * 5 + 2 * 7 + 1;

extern "C" void kernel_launch(void* const* d_in, const int* in_sizes, int n_in, void* d_out, int out_size, void* d_ws, size_t ws_size, hipStream_t stream) {
    static int grid = 0;
    if (grid == 0) {
        if (n_in != 25 || out_size != T * DM || ws_size < WS_END) { fprintf(stderr, "kernel_launch: unexpected sizes n_in %d out %d ws %zu\n", n_in, out_size, ws_size); grid = -1; return; }
        int dev = 0, cus = 0, per_cu = 0;
        hipGetDevice(&dev); hipDeviceGetAttribute(&cus, hipDeviceAttributeMultiprocessorCount, dev);
        hipFuncSetAttribute((const void*)mk_fwd, hipFuncAttributeMaxDynamicSharedMemorySize, LDS_BYTES);
        hipOccupancyMaxActiveBlocksPerMultiprocessor(&per_cu, (const void*)mk_fwd, NTHREADS, LDS_BYTES);
        if (per_cu < 1) per_cu = 1;
        grid = cus * per_cu;
        (void)hipGetLastError();
    }
    if (grid < 0) return;
    Params p{};
    for (int i = 0; i < 25; ++i) p.in[i] = (const float*)d_in[i];
    p.out = (float*)d_out; p.ws = (unsigned char*)d_ws;
    (void)hipMemsetAsync((unsigned char*)d_ws + WS_BAR, 0, BAR_BYTES, stream);
#if MK_MULTI
    for (int ph = 0; ph < N_PHASES; ++ph) { p.ph_lo = ph; p.ph_hi = ph + 1; hipLaunchKernelGGL(mk_fwd, dim3(grid), dim3(NTHREADS), LDS_BYTES, stream, p); }
#else
    p.ph_lo = 0; p.ph_hi = N_PHASES;
    void* args[] = {&p};
    hipError_t e = hipLaunchCooperativeKernel((const void*)mk_fwd, dim3(grid), dim3(NTHREADS), args, LDS_BYTES, stream);
    if (e != hipSuccess) fprintf(stderr, "cooperative launch failed: %s (grid %d)\n", hipGetErrorString(e), grid);
#endif
}
```

```cpp
#include <hip/hip_runtime.h>
#include <hip/hip_cooperative_groups.h>
#include <cstdio>
#include <cstdint>
namespace cg = cooperative_groups;

#ifndef MK_MULTI
#define MK_MULTI 0
#endif

#define LAS __attribute__((address_space(3)))
typedef unsigned short bf16_t;
typedef short bf16x8 __attribute__((ext_vector_type(8)));
typedef short s16x4 __attribute__((ext_vector_type(4)));
typedef float f32x2 __attribute__((ext_vector_type(2)));
typedef float f32x4 __attribute__((ext_vector_type(4)));
typedef float f32x16 __attribute__((ext_vector_type(16)));
typedef unsigned u32x2 __attribute__((ext_vector_type(2)));
typedef unsigned u32x4 __attribute__((ext_vector_type(4)));

constexpr int T = 32768, TP = 16384, DM = 1024, FF = 2816;
constexpr int EV_IN = 2208, EV_INP = 2304, OD_IN = 1792;
constexpr float LOG2E = 1.4426950408889634f;
constexpr float EPS = 1e-6f;

constexpr size_t MiB = 1u << 20;
constexpr size_t WS_ROPE = 0, WS_AGG = 1 * MiB, WS_BAR = 7 * MiB, BAR_BYTES = 32768, WS_W = 7 * MiB + 65536, WS_XN = 170 * MiB, WS_BIG = 234 * MiB, WS_END = 442 * MiB;
constexpr size_t W_GU = 0, W_GU_SZ = (size_t)5632 * 1024;
constexpr size_t W_DN = W_GU + 8 * W_GU_SZ, W_DN_SZ = (size_t)1024 * 2816;
constexpr size_t W_EVIN = W_DN + 8 * W_DN_SZ, W_EVIN_SZ = (size_t)EV_INP * 1024;
constexpr size_t W_UQ = W_EVIN + 2 * W_EVIN_SZ, W_UQ_SZ = (size_t)768 * 384;
constexpr size_t W_UKV = W_UQ + 2 * W_UQ_SZ, W_UKV_SZ = (size_t)1024 * 256;
constexpr size_t W_EVOUT = W_UKV + 2 * W_UKV_SZ, W_SQ_SZ = (size_t)1024 * 1024;
constexpr size_t W_ODIN = W_EVOUT + 2 * W_SQ_SZ, W_ODIN_SZ = (size_t)OD_IN * 1024;
constexpr size_t W_LRU = W_ODIN + 2 * W_ODIN_SZ, W_LRU_SZ = (size_t)2048 * 512;
constexpr size_t W_ODOUT = W_LRU + 2 * W_LRU_SZ;
constexpr size_t W_TOTAL = W_ODOUT + 2 * W_SQ_SZ;
static_assert(WS_W + W_TOTAL * 2 <= WS_XN, "weights fit");
constexpr size_t B_ACT = 0;
constexpr int ZLD = 2816;
constexpr size_t B_Z = 0, O_Q = 64 * MiB, O_KPE = 112 * MiB;
constexpr size_t B_Z2 = 0, B_XC = 176 * MiB, O_U = 64 * MiB;

constexpr int LDS_BYTES = 147456;
constexpr int NTHREADS = 512;

__device__ __forceinline__ unsigned cvt_pk_bf16(float lo, float hi) { unsigned r; asm volatile("v_cvt_pk_bf16_f32 %0, %1, %2" : "=v"(r) : "v"(lo), "v"(hi)); return r; }
__device__ __forceinline__ float bf_lo(unsigned w) { return __uint_as_float(w << 16); }
__device__ __forceinline__ float bf_hi(unsigned w) { return __uint_as_float(w & 0xffff0000u); }
__device__ __forceinline__ float bf2f(bf16_t b) { return __uint_as_float((unsigned)b << 16); }
template <int O> __device__ __forceinline__ float swz_xor(float v) { return __builtin_bit_cast(float, __builtin_amdgcn_ds_swizzle(__builtin_bit_cast(int, v), 0x1F | (O << 10))); }
__device__ __forceinline__ float wave_sum(float v) {
    v += swz_xor<1>(v); v += swz_xor<2>(v); v += swz_xor<4>(v); v += swz_xor<8>(v); v += swz_xor<16>(v);
    auto rr = __builtin_amdgcn_permlane32_swap(__float_as_uint(v), __float_as_uint(v), false, false);
    return __uint_as_float(rr[0]) + __uint_as_float(rr[1]);
}
__device__ __forceinline__ float fq_sum(float v) {
    v += swz_xor<16>(v);
    auto rr = __builtin_amdgcn_permlane32_swap(__float_as_uint(v), __float_as_uint(v), false, false);
    return __uint_as_float(rr[0]) + __uint_as_float(rr[1]);
}
__device__ __forceinline__ float row_rstd(const float* part, int row, int fq) {
    const f32x4 p = *(const f32x4*)(part + (size_t)row * 16 + 4 * fq);
    return rsqrtf(fq_sum((p.x + p.y) + (p.z + p.w)) * (1.f / DM) + EPS);
}
__device__ __forceinline__ float sigmoidf_(float x) { return __builtin_amdgcn_rcpf(1.0f + __builtin_amdgcn_exp2f(-x * LOG2E)); }

namespace pg8 {
constexpr int BM = 256, BK = 64, HALF = 128, HTB = HALF * BK * 2, STAGE_BYTES = 8 * HTB, NXCD = 8, WGM = 8;
__host__ __device__ __forceinline__ int lds_byte(int r, int c) { const int st = (r >> 4) * 2 + (c >> 5), rr = r & 15, cc = c & 31, ob = rr * 64 + cc * 2; return st * 1024 + (ob ^ (((ob >> 9) & 1) << 5)); }
__host__ __device__ __forceinline__ void stage_rc(int b, int& R, int& C) { const int st = b / 1024, sb = b % 1024, swz = sb ^ (((sb >> 9) & 1) << 5); R = (st >> 1) * 16 + swz / 64; C = (st & 1) * 32 + (swz % 64) / 2; }
__host__ __device__ __forceinline__ int perm32(int rho) { const int n = rho >> 4, i = rho & 15; return 8 * (i >> 2) + 4 * n + (i & 3); }

struct Unit { int pm, pn; };
struct Gemm { const bf16_t* A; const bf16_t* Bt; int lda, M, N, K, kslice; };

struct StaticOrder {
    int nM, nN, nwg, G, c;
    __device__ void init(int M, int N, int G_, int c_) { nM = M / BM; nN = N / BM; nwg = nM * nN; G = G_; c = c_; }
    __device__ bool next(int i, Unit& u) const {
        const long L = (long)i * G + c; if (L >= nwg) return false;
        int wgid = (int)L; { const int q = nwg / NXCD, r = nwg % NXCD, xcd = wgid % NXCD, off = wgid / NXCD; wgid = (xcd < r ? xcd * (q + 1) : r * (q + 1) + (xcd - r) * q) + off; }
        const int nig = WGM * nN, gid = wgid / nig, fm = gid * WGM, gsz = (nM - fm) < WGM ? (nM - fm) : WGM;
        u.pm = fm + ((wgid % nig) % gsz); u.pn = (wgid % nig) / gsz; return true;
    }
};

template <class Epi, bool ALIGN_EPI>
__device__ __forceinline__ void gemm_phase(LAS unsigned char* lds, const Gemm g, const StaticOrder S, const Epi E) {
    int tid = threadIdx.x; asm volatile("" : "+v"(tid));
    const int wid = __builtin_amdgcn_readfirstlane(tid >> 6), lane = tid & 63, wr = wid >> 2, wc = wid & 3, fr = lane & 15, fq = lane >> 4;
    const int K = g.K, nt = (g.kslice ? g.kslice : K) / BK, lda = g.lda;
#define PG8_KOFS(u_) (g.kslice ? (size_t)((u_).pn & 3) * (size_t)g.kslice * 2 : (size_t)0)
    unsigned voffA[2], voffB[2];
#pragma unroll
    for (int i = 0; i < 2; ++i) { int R, C; stage_rc(tid * 16 + i * 8192, R, C); const int Rb = Epi::PERM ? ((R & ~31) + perm32(R & 31)) : R;
        voffA[i] = (unsigned)(R * lda + C) * 2u; voffB[i] = (unsigned)(Rb * K + C) * 2u; }
    const size_t kstep = (size_t)(BK * 2);
    const size_t hstepA = (size_t)HALF * lda * 2, hstepB = (size_t)HALF * K * 2;
    const size_t tstepA = 2 * hstepA, tstepB = 2 * hstepB;
    const unsigned ldsw = (unsigned)wid * 1024u;
    const int aoff = lds_byte(wr * 64 + fr, fq * 8), boff = lds_byte(wc * 32 + fr, fq * 8);
#define PG8_SA(b, h) (((b) * 2 + (h)) * HTB)
#define PG8_SB(b, h) ((4 + (b) * 2 + (h)) * HTB)
#define PG8_STAGE(bufoff, gbase, voff) do { _Pragma("unroll") for (int _i = 0; _i < 2; ++_i) \
        __builtin_amdgcn_global_load_lds((const unsigned*)((const char*)(gbase) + (voff)[_i]), (LAS unsigned*)(lds + (bufoff) + ldsw + _i * 8192), 16, 0, 0); } while (0)
#define PG8_LDA(dst, b, h) do { _Pragma("unroll") for (int m = 0; m < 4; ++m) _Pragma("unroll") for (int k = 0; k < 2; ++k) dst[m][k] = *(const LAS bf16x8*)(lds + PG8_SA(b, h) + aoff + m * 2048 + k * 1024); } while (0)
#define PG8_LDB(dst, b, h) do { _Pragma("unroll") for (int n = 0; n < 2; ++n) _Pragma("unroll") for (int k = 0; k < 2; ++k) dst[n][k] = *(const LAS bf16x8*)(lds + PG8_SB(b, h) + boff + n * 2048 + k * 1024); } while (0)
#define PG8_MMA(ai, bj, At, Bt) do { __builtin_amdgcn_s_setprio(1); _Pragma("unroll") for (int m = 0; m < 4; ++m) _Pragma("unroll") for (int n = 0; n < 2; ++n) _Pragma("unroll") for (int k = 0; k < 2; ++k) \
        acc[ai][bj][m][n] = __builtin_amdgcn_mfma_f32_16x16x32_bf16(Bt[n][k], At[m][k], acc[ai][bj][m][n], 0, 0, 0); __builtin_amdgcn_s_setprio(0); } while (0)
#define PG8_WAIT_V(n) asm volatile("s_waitcnt vmcnt(" #n ")" ::: "memory")
#define PG8_WAIT_L(n) asm volatile("s_waitcnt lgkmcnt(" #n ")" ::: "memory")
#define PG8_BAR __builtin_amdgcn_s_barrier()
#define PG8_SCHED __builtin_amdgcn_sched_barrier(0)
    Unit cur, nxt; int ui = 0;
    if (!S.next(0, cur)) return;
    float rs[2][4], rsp[2][4];
#define PG8_RS_ISSUE(u_) do { if constexpr (Epi::ROWSCALE) { _Pragma("unroll") for (int ai_ = 0; ai_ < 2; ++ai_) _Pragma("unroll") for (int m_ = 0; m_ < 4; ++m_) { \
        const f32x4 p_ = *(const f32x4*)(E.part + (size_t)((u_).pm * BM + ai_ * HALF + wr * 64 + m_ * 16 + fr) * 16 + 4 * fq); rsp[ai_][m_] = (p_.x + p_.y) + (p_.z + p_.w); } } } while (0)
#define PG8_RS_FINISH() do { if constexpr (Epi::ROWSCALE) { _Pragma("unroll") for (int ai_ = 0; ai_ < 2; ++ai_) _Pragma("unroll") for (int m_ = 0; m_ < 4; ++m_) rs[ai_][m_] = rsqrtf(fq_sum(rsp[ai_][m_]) * (1.f / DM) + EPS); } \
        else { _Pragma("unroll") for (int ai_ = 0; ai_ < 2; ++ai_) _Pragma("unroll") for (int m_ = 0; m_ < 4; ++m_) rs[ai_][m_] = 1.f; } } while (0)
    PG8_RS_ISSUE(cur);
    f32x4 acc[2][2][4][2];
#pragma unroll
    for (int a = 0; a < 2; ++a)
#pragma unroll
        for (int b = 0; b < 2; ++b)
#pragma unroll
            for (int m = 0; m < 4; ++m)
#pragma unroll
                for (int n = 0; n < 2; ++n) acc[a][b][m][n] = (f32x4){0.f, 0.f, 0.f, 0.f};
    bf16x8 At[4][2], B0[2][2], B1[2][2];
    const char* cA = (const char*)g.A + (size_t)cur.pm * tstepA + PG8_KOFS(cur); const char* cB = (const char*)g.Bt + (size_t)cur.pn * tstepB + PG8_KOFS(cur);
    PG8_STAGE(PG8_SB(0, 0), cB, voffB); PG8_STAGE(PG8_SB(0, 1), cB + hstepB, voffB); PG8_STAGE(PG8_SA(0, 0), cA, voffA); PG8_STAGE(PG8_SA(0, 1), cA + hstepA, voffA);
    if (wr == 1) PG8_BAR;
    PG8_WAIT_V(2); PG8_BAR;
    PG8_STAGE(PG8_SB(1, 0), cB + kstep, voffB); PG8_STAGE(PG8_SA(1, 0), cA + kstep, voffA); PG8_STAGE(PG8_SB(1, 1), cB + hstepB + kstep, voffB);
    PG8_WAIT_V(6); PG8_BAR;
    PG8_RS_FINISH();
    for (;;) {
        const bool has_next = S.next(ui + 1, nxt);
        const char* nA = has_next ? (const char*)g.A + (size_t)nxt.pm * tstepA + PG8_KOFS(nxt) : cA; const char* nB = has_next ? (const char*)g.Bt + (size_t)nxt.pn * tstepB + PG8_KOFS(nxt) : cB;
#pragma unroll 1
        for (int t = 0; t < nt; t += 2) {
            const bool last = (t == nt - 2);
            const char* a1 = cA + (size_t)(t + 1) * kstep;
            const char* a2 = last ? nA : cA + (size_t)(t + 2) * kstep; const char* b2 = last ? nB : cB + (size_t)(t + 2) * kstep;
            const char* a3 = a2 + kstep; const char* b3 = b2 + kstep;
            PG8_LDB(B0, 0, 0); PG8_LDB(B1, 0, 1); PG8_SCHED; PG8_LDA(At, 0, 0); PG8_STAGE(PG8_SA(1, 1), a1 + hstepA, voffA);
            PG8_WAIT_V(8); PG8_WAIT_L(0); PG8_BAR; PG8_MMA(0, 0, At, B0); PG8_MMA(0, 1, At, B1); PG8_BAR; PG8_SCHED;
            PG8_LDA(At, 0, 1); PG8_STAGE(PG8_SB(0, 0), b2, voffB); PG8_STAGE(PG8_SB(0, 1), b2 + hstepB, voffB); PG8_STAGE(PG8_SA(0, 0), a2, voffA);
            PG8_WAIT_V(8); PG8_WAIT_L(0); PG8_BAR; PG8_MMA(1, 0, At, B0); PG8_MMA(1, 1, At, B1); PG8_BAR; PG8_SCHED;
            PG8_LDB(B0, 1, 0); PG8_LDB(B1, 1, 1); PG8_SCHED; PG8_LDA(At, 1, 0); PG8_STAGE(PG8_SA(0, 1), a2 + hstepA, voffA);
            PG8_WAIT_V(8); PG8_WAIT_L(0); PG8_BAR; PG8_MMA(0, 0, At, B0); PG8_MMA(0, 1, At, B1); PG8_BAR; PG8_SCHED;
            PG8_LDA(At, 1, 1); PG8_STAGE(PG8_SB(1, 0), b3, voffB); PG8_STAGE(PG8_SB(1, 1), b3 + hstepB, voffB); PG8_STAGE(PG8_SA(1, 0), a3, voffA);
            PG8_WAIT_V(8); PG8_WAIT_L(0); PG8_BAR; PG8_MMA(1, 0, At, B0); PG8_MMA(1, 1, At, B1); PG8_BAR; PG8_SCHED;
        }
        if constexpr (ALIGN_EPI) { if (wr == 0) PG8_BAR; }
        if (has_next) PG8_RS_ISSUE(nxt);
        E(acc, cur, wr, wc, fr, fq, rs);
        if (!has_next) break;
        PG8_RS_FINISH();
#pragma unroll
        for (int a = 0; a < 2; ++a)
#pragma unroll
            for (int b = 0; b < 2; ++b)
#pragma unroll
                for (int m = 0; m < 4; ++m)
#pragma unroll
                    for (int n = 0; n < 2; ++n) acc[a][b][m][n] = (f32x4){0.f, 0.f, 0.f, 0.f};
        cur = nxt; cA = nA; cB = nB; ++ui;
        if constexpr (ALIGN_EPI) { if (wr == 1) PG8_BAR; }
    }
    PG8_WAIT_V(0);
    if constexpr (!ALIGN_EPI) { if (wr == 0) PG8_BAR; }
    PG8_BAR;
#undef PG8_KOFS
#undef PG8_RS_ISSUE
#undef PG8_RS_FINISH
#undef PG8_SA
#undef PG8_SB
#undef PG8_STAGE
#undef PG8_LDA
#undef PG8_LDB
#undef PG8_MMA
#undef PG8_WAIT_V
#undef PG8_WAIT_L
#undef PG8_BAR
#undef PG8_SCHED
}

template <bool SCALE> struct EpiStore {
    static constexpr bool PERM = true, ROWSCALE = SCALE;
    bf16_t* O; int ldc; const float* part;
    __device__ __forceinline__ void operator()(const f32x4 (&acc)[2][2][4][2], const Unit& u, int wr, int wc, int fr, int fq, const float (&rs)[2][4]) const {
        asm volatile("" : "+v"(fr), "+v"(fq));
        const int row0 = u.pm * BM + wr * 64 + fr, col0 = u.pn * BM + wc * 32 + 8 * fq;
#pragma unroll
        for (int ai = 0; ai < 2; ++ai)
#pragma unroll
            for (int m = 0; m < 4; ++m) { bf16_t* rowp = O + (size_t)(row0 + ai * HALF + m * 16) * ldc + col0;
                const float rsv = SCALE ? rs[ai][m] : 1.0f;
#pragma unroll
                for (int bj = 0; bj < 2; ++bj) { const f32x4 v0 = acc[ai][bj][m][0] * rsv, v1 = acc[ai][bj][m][1] * rsv;
                    u32x4 w; w.x = cvt_pk_bf16(v0[0], v0[1]); w.y = cvt_pk_bf16(v0[2], v0[3]); w.z = cvt_pk_bf16(v1[0], v1[1]); w.w = cvt_pk_bf16(v1[2], v1[3]);
                    *(u32x4*)(rowp + bj * HALF) = w; } }
    }
};
struct EpiSwiglu {
    static constexpr bool PERM = true, ROWSCALE = true;
    bf16_t* O; const float* part;
    __device__ __forceinline__ void operator()(const f32x4 (&acc)[2][2][4][2], const Unit& u, int wr, int wc, int fr, int fq, const float (&rs)[2][4]) const {
        asm volatile("" : "+v"(fr), "+v"(fq));
        const int row0 = u.pm * BM + wr * 64 + fr, col0 = u.pn * HALF + wc * 32 + 8 * fq;
#pragma unroll
        for (int ai = 0; ai < 2; ++ai)
#pragma unroll
            for (int m = 0; m < 4; ++m) { bf16_t* rowp = O + (size_t)(row0 + ai * HALF + m * 16) * FF + col0;
                float r[8], e[8]; const float rsv = rs[ai][m]; const float c1 = -rsv * LOG2E, c2 = rsv * rsv;
#pragma unroll
                for (int j = 0; j < 8; ++j) { const float gv = acc[ai][0][m][j >> 2][j & 3], uv = acc[ai][1][m][j >> 2][j & 3]; e[j] = gv * c1; r[j] = gv * uv; }
                __builtin_amdgcn_sched_barrier(0);
#pragma unroll
                for (int j = 0; j < 8; ++j) e[j] = __builtin_amdgcn_exp2f(e[j]);
                __builtin_amdgcn_sched_barrier(0);
#pragma unroll
                for (int j = 0; j < 8; ++j) e[j] = 1.0f + e[j];
                __builtin_amdgcn_sched_barrier(0);
#pragma unroll
                for (int j = 0; j < 8; ++j) e[j] = __builtin_amdgcn_rcpf(e[j]);
                __builtin_amdgcn_sched_barrier(0);
#pragma unroll
                for (int j = 0; j < 8; ++j) r[j] = r[j] * (c2 * e[j]);
                u32x4 w; w.x = cvt_pk_bf16(r[0], r[1]); w.y = cvt_pk_bf16(r[2], r[3]); w.z = cvt_pk_bf16(r[4], r[5]); w.w = cvt_pk_bf16(r[6], r[7]);
                *(u32x4*)rowp = w; }
    }
};
struct EpiRes {
    static constexpr bool PERM = true, ROWSCALE = false;
    bf16_t* X; float* part; float alpha;
    __device__ __forceinline__ void operator()(const f32x4 (&acc)[2][2][4][2], const Unit& u, int wr, int wc, int fr, int fq, const float (&rs)[2][4]) const {
        asm volatile("" : "+v"(fr), "+v"(fq));
        const int row0 = u.pm * BM + wr * 64 + fr, col0 = u.pn * BM + wc * 32 + 8 * fq;
#pragma unroll
        for (int ai = 0; ai < 2; ++ai) {
#pragma unroll
            for (int m = 0; m < 4; ++m) { bf16_t* rowp = X + (size_t)(row0 + ai * HALF + m * 16) * DM + col0; float ss = 0.f;
#pragma unroll
                for (int bj = 0; bj < 2; ++bj) { const u32x4 bw = *(const u32x4*)(rowp + bj * HALF); const f32x4 a0 = acc[ai][bj][m][0], a1 = acc[ai][bj][m][1];
                    u32x4 w; w.x = cvt_pk_bf16(bf_lo(bw.x) + alpha * a0[0], bf_hi(bw.x) + alpha * a0[1]); w.y = cvt_pk_bf16(bf_lo(bw.y) + alpha * a0[2], bf_hi(bw.y) + alpha * a0[3]);
                    w.z = cvt_pk_bf16(bf_lo(bw.z) + alpha * a1[0], bf_hi(bw.z) + alpha * a1[1]); w.w = cvt_pk_bf16(bf_lo(bw.w) + alpha * a1[2], bf_hi(bw.w) + alpha * a1[3]);
                    *(u32x4*)(rowp + bj * HALF) = w;
                    ss += (bf_lo(w.x) * bf_lo(w.x) + bf_hi(w.x) * bf_hi(w.x)) + (bf_lo(w.y) * bf_lo(w.y) + bf_hi(w.y) * bf_hi(w.y));
                    ss += (bf_lo(w.z) * bf_lo(w.z) + bf_hi(w.z) * bf_hi(w.z)) + (bf_lo(w.w) * bf_lo(w.w) + bf_hi(w.w) * bf_hi(w.w)); }
                ss = fq_sum(ss);
                if (fq == 0) part[(size_t)(row0 + ai * HALF + m * 16) * 16 + u.pn * 4 + wc] = ss; } }
    }
};
struct EpiQRope {
    static constexpr bool PERM = true, ROWSCALE = false;
    bf16_t* O; const float* tab;
    __device__ __forceinline__ void operator()(const f32x4 (&acc)[2][2][4][2], const Unit& u, int wr, int wc, int fr, int fq, const float (&rs)[2][4]) const {
        asm volatile("" : "+v"(fr), "+v"(fq));
        const int row0 = u.pm * BM + wr * 64 + fr;
        const int pmask = (u.pm < TP / BM) ? 8191 : 4095;
#pragma unroll
        for (int bj = 0; bj < 2; ++bj) {
            const int cb = u.pn * BM + bj * HALF + wc * 32 + 8 * fq; const int d = cb % 96; const bool rope = d >= 64; const int i0 = rope ? ((d - 64) >> 1) : 0;
#pragma unroll
            for (int ai = 0; ai < 2; ++ai)
#pragma unroll
                for (int m = 0; m < 4; ++m) { const int row = row0 + ai * HALF + m * 16; f32x4 v0 = acc[ai][bj][m][0], v1 = acc[ai][bj][m][1];
                    if (rope) { const float* cs = tab + ((size_t)(row & pmask) * 16 + i0) * 2; const f32x4 c01 = *(const f32x4*)cs, c23 = *(const f32x4*)(cs + 4);
                        const f32x4 a = v0, b = v1;
                        v0[0] = a[0] * c01[0] - a[1] * c01[1]; v0[1] = a[0] * c01[1] + a[1] * c01[0];
                        v0[2] = a[2] * c01[2] - a[3] * c01[3]; v0[3] = a[2] * c01[3] + a[3] * c01[2];
                        v1[0] = b[0] * c23[0] - b[1] * c23[1]; v1[1] = b[0] * c23[1] + b[1] * c23[0];
                        v1[2] = b[2] * c23[2] - b[3] * c23[3]; v1[3] = b[2] * c23[3] + b[3] * c23[2]; }
                    u32x4 w; w.x = cvt_pk_bf16(v0[0], v0[1]); w.y = cvt_pk_bf16(v0[2], v0[3]); w.z = cvt_pk_bf16(v1[0], v1[1]); w.w = cvt_pk_bf16(v1[2], v1[3]);
                    *(u32x4*)(O + (size_t)row * 768 + cb) = w;
                    asm volatile("" ::: "memory"); }
        }
    }
};
struct EpiLru {
    static constexpr bool PERM = true, ROWSCALE = false;
    bf16_t* LA; bf16_t* U; const bf16_t* XC; const float* b_a; const float* b_x; const float* lam;
    __device__ __forceinline__ void operator()(const f32x4 (&acc)[2][2][4][2], const Unit& u, int wr, int wc, int fr, int fq, const float (&rs)[2][4]) const {
        asm volatile("" : "+v"(fr), "+v"(fq));
        const int row0 = u.pm * BM + wr * 64 + fr; const int dir = u.pn >> 2, cbase = (u.pn & 3) * HALF + wc * 32 + 8 * fq;
        float ba[8], bx[8], sp[8];
#pragma unroll
        for (int j = 0; j < 8; ++j) { ba[j] = b_a[dir * 512 + cbase + j]; bx[j] = b_x[dir * 512 + cbase + j];
            const float e = __expf(-lam[dir * 512 + cbase + j]);
            sp[j] = 8.0f * LOG2E * (e < 0.02f ? e * (1.0f - e * (0.5f - e * (0.33333333f - 0.25f * e))) : __logf(1.0f + e)); }
#pragma unroll
        for (int ai = 0; ai < 2; ++ai)
#pragma unroll
            for (int m = 0; m < 4; ++m) { const int row = row0 + ai * HALF + m * 16;
                const u32x4 xw = *(const u32x4*)(XC + (size_t)row * 512 + cbase);
                float xc[8] = {bf_lo(xw.x), bf_hi(xw.x), bf_lo(xw.y), bf_hi(xw.y), bf_lo(xw.z), bf_hi(xw.z), bf_lo(xw.w), bf_hi(xw.w)};
                float la[8], uu[8];
#pragma unroll
                for (int j = 0; j < 8; ++j) { const float r = sigmoidf_(acc[ai][0][m][j >> 2][j & 3] + ba[j]), ig = sigmoidf_(acc[ai][1][m][j >> 2][j & 3] + bx[j]);
                    la[j] = -r * sp[j]; const float a2 = __builtin_amdgcn_exp2f(2.0f * la[j]); uu[j] = __builtin_sqrtf(fmaxf(1.0f - a2, 0.0f)) * ig * xc[j]; }
                u32x4 w; w.x = cvt_pk_bf16(la[0], la[1]); w.y = cvt_pk_bf16(la[2], la[3]); w.z = cvt_pk_bf16(la[4], la[5]); w.w = cvt_pk_bf16(la[6], la[7]);
                *(u32x4*)(LA + (size_t)row * 1024 + dir * 512 + cbase) = w;
                w.x = cvt_pk_bf16(uu[0], uu[1]); w.y = cvt_pk_bf16(uu[2], uu[3]); w.z = cvt_pk_bf16(uu[4], uu[5]); w.w = cvt_pk_bf16(uu[6], uu[7]);
                *(u32x4*)(U + (size_t)row * 1024 + dir * 512 + cbase) = w; }
    }
};
}

template <class Epi, bool ALIGN>
__device__ __forceinline__ void run_gemm(LAS unsigned char* lds, const bf16_t* A, int lda, const bf16_t* Bt, int N, int K, const Epi E, int cidx, int kslice = 0) {
    pg8::Gemm g{A, Bt, lda, T, N, K, kslice}; pg8::StaticOrder S; S.init(T, N, (int)gridDim.x, cidx);
    pg8::gemm_phase<Epi, ALIGN>(lds, g, S, E);
}

namespace att {
typedef LAS const char* lds_cptr;
typedef short v4i16_t __attribute__((ext_vector_type(4)));
constexpr int KSLOT = 12288, VSLOT = 8192;
constexpr int LDS_K = 0, LDS_V = 2 * KSLOT, LDS_WS = LDS_V + 3 * VSLOT, LDS_OST = LDS_WS + 8 * 256, LDS_END = LDS_OST + 8 * 4096;
__device__ __forceinline__ int crow(int r, int hi) { return (r & 3) + 8 * (r >> 2) + 4 * hi; }
__device__ __forceinline__ void glds16(const void* gsrc, unsigned lds_dst) { unsigned keep;
    asm volatile("s_mov_b32 %0, m0\n\ts_mov_b32 m0, %2\n\ts_nop 0\n\tglobal_load_lds_dwordx4 %1, off\n\ts_mov_b32 m0, %0" : "=&s"(keep) : "v"(gsrc), "s"(lds_dst) : "memory"); }
__device__ __forceinline__ s16x4 vtr(lds_cptr p) { return __builtin_bit_cast(s16x4, __builtin_amdgcn_ds_read_tr16_b64_v4i16((LAS v4i16_t*)p)); }
__device__ __forceinline__ float halfmax(float m) { auto rr = __builtin_amdgcn_permlane32_swap(__float_as_uint(m), __float_as_uint(m), false, false); return fmaxf(__uint_as_float(rr[0]), __uint_as_float(rr[1])); }
__device__ __forceinline__ float halfsum(float m) { auto rr = __builtin_amdgcn_permlane32_swap(__float_as_uint(m), __float_as_uint(m), false, false); return __uint_as_float(rr[0]) + __uint_as_float(rr[1]); }

struct Unit { const bf16_t* Q; int ldq; const bf16_t* K; int ldk; const bf16_t* KPE; const bf16_t* V; int ldv; bf16_t* O; int ldo; int t_lo, t_hi, qpos0; float slope2, sink2; };

template <int MODE> __device__ __forceinline__ void attn_unit(const Unit& a, char* shm) {
    constexpr int ND = MODE == 0 ? 6 : 4;
    constexpr float THR = 8.0f;
    int tid = threadIdx.x; asm volatile("" : "+v"(tid));
    const int lane = tid & 63, r32 = lane & 31, hi = lane >> 5; const int wid = __builtin_amdgcn_readfirstlane(tid >> 6);
    const unsigned lds0 = (unsigned)(uintptr_t)shm; const lds_cptr shm3 = (lds_cptr)shm;
    LAS float* wsf = (LAS float*)(shm3 + LDS_WS) + wid * 64;
    const bf16_t* ksrc = a.K + (long)lane * a.ldk + wid * 8;
    const bf16_t* kpsrc = a.KPE + (long)lane * 32 + (wid & 3) * 8;
    const bf16_t* vsrc = a.V + (long)(16 * (wid & 3) + (lane >> 2)) * a.ldv + (wid >> 2) * 32 + (lane & 3) * 8;
    const unsigned kdst = lds0 + LDS_K + wid * 1024, kpdst = lds0 + LDS_K + (8 + (wid & 3)) * 1024, vdst = lds0 + LDS_V + wid * 1024;
#define ATT_DMA(t, sk, sv) do { glds16(ksrc + (long)(t) * 64 * a.ldk, (unsigned)__builtin_amdgcn_readfirstlane(kdst + (sk) * KSLOT)); \
        if (MODE == 0 && wid < 4) glds16(kpsrc + (long)(t) * 64 * 32, (unsigned)__builtin_amdgcn_readfirstlane(kpdst + (sk) * KSLOT)); \
        glds16(vsrc + (long)(t) * 64 * a.ldv, (unsigned)__builtin_amdgcn_readfirstlane(vdst + (sv) * VSLOT)); } while (0)
#define ATT_WAIT_BAR() asm volatile("s_waitcnt vmcnt(0) lgkmcnt(0)\n\ts_barrier" ::: "memory")
#define ATT_PV(PW, vslot) do { const lds_cptr vp_ = vp0 + (vslot) * VSLOT; \
        _Pragma("unroll") for (int d0 = 0; d0 < 2; ++d0) _Pragma("unroll") for (int ks = 0; ks < 4; ++ks) { \
            const s16x4 lo_ = vtr(vp_ + d0 * 4096 + ks * 1024), hh_ = vtr(vp_ + d0 * 4096 + ks * 1024 + 512); \
            const bf16x8 vf_ = (bf16x8){lo_[0], lo_[1], lo_[2], lo_[3], hh_[0], hh_[1], hh_[2], hh_[3]}; \
            o[d0] = __builtin_amdgcn_mfma_f32_32x32x16_bf16(__builtin_bit_cast(bf16x8, (PW)[ks]), vf_, o[d0], 0, 0, 0); } } while (0)
    const int g = wid >> 2;
    ATT_DMA(a.t_lo, 0, 0);
    bf16x8 qr[ND];
    { const bf16_t* Qw = a.Q + (long)(wid * 32 + r32) * a.ldq + hi * 8;
#pragma unroll
      for (int d0 = 0; d0 < ND; ++d0) qr[d0] = *(const bf16x8*)(Qw + d0 * 16); }
    float mhat = (MODE == 1) ? a.sink2 : 0.f;
    float l_reg = (MODE == 1 && hi == 0) ? 1.f : 0.f;
    f32x16 o[2]; o[0] = f32x16{}; o[1] = f32x16{};
    f32x16 negm;
#pragma unroll
    for (int r = 0; r < 16; ++r) negm[r] = -mhat;
    const int tq0 = a.qpos0 + wid * 32, tq = tq0 + r32;
    const lds_cptr vp0 = shm3 + LDS_V + ((lane >> 4) & 1) * 32 + (lane & 3) * 8 + (4 * hi + ((lane & 15) >> 2)) * 64;
    u32x4 pw[4]; pw[0] = (u32x4){0u, 0u, 0u, 0u}; pw[1] = pw[0]; pw[2] = pw[0]; pw[3] = pw[0];
    bool pend = false; int sv = 0, svp = 0;
    for (int t = a.t_lo; t < a.t_hi; ++t) {
        const int s = (t - a.t_lo) & 1;
        ATT_WAIT_BAR();
        if (t + 1 < a.t_hi) ATT_DMA(t + 1, s ^ 1, (sv == 2 ? 0 : sv + 1));
        if (pend) { ATT_PV(pw, svp); pend = false; }
        bool active = true;
        if (MODE == 1) active = (64 * t + 63 >= tq0 - 128) && (64 * t <= tq0 + 31 + 128);
        if (active) {
            const lds_cptr kp = shm3 + LDS_K + s * KSLOT + hi * 1024 + r32 * 16;
            f32x16 p0 = negm, p1 = negm;
#pragma unroll
            for (int d0 = 0; d0 < ND; ++d0) {
                const bf16x8 b0 = *(const LAS bf16x8*)(kp + d0 * 2048), b1 = *(const LAS bf16x8*)(kp + d0 * 2048 + 512);
                p0 = __builtin_amdgcn_mfma_f32_32x32x16_bf16(b0, qr[d0], p0, 0, 0, 0);
                p1 = __builtin_amdgcn_mfma_f32_32x32x16_bf16(b1, qr[d0], p1, 0, 0, 0);
            }
            if (MODE == 1) {
#pragma unroll
                for (int r = 0; r < 16; ++r) { const int ks = 64 * t + crow(r, hi); const int r0 = abs(tq - ks), r1 = abs(tq - ks - 32);
                    p0[r] = (r0 <= 128) ? p0[r] - a.slope2 * (float)r0 : -INFINITY; p1[r] = (r1 <= 128) ? p1[r] - a.slope2 * (float)r1 : -INFINITY; }
            }
#define MX3(a_, b_, c_) __builtin_fmaxf(__builtin_fmaxf((a_), (b_)), (c_))
            float ra = MX3(p0[0], p0[1], p1[0]), rb = MX3(p0[2], p0[3], p1[1]); ra = MX3(ra, p1[2], p1[3]);
#pragma unroll
            for (int r = 4; r < 16; r += 4) { ra = MX3(ra, p0[r], p0[r + 1]); rb = MX3(rb, p0[r + 2], p0[r + 3]); ra = MX3(ra, p1[r], p1[r + 1]); rb = MX3(rb, p1[r + 2], p1[r + 3]); }
#undef MX3
            float rm = halfmax(__builtin_fmaxf(ra, rb));
            const bool first = (MODE == 0) && (t == a.t_lo);
            if (first || __any(rm > THR)) {
                const float dl = first ? rm : fmaxf(rm, 0.f);
                mhat += dl;
#pragma unroll
                for (int r = 0; r < 16; ++r) { p0[r] -= dl; p1[r] -= dl; negm[r] = -mhat; }
                if (!first) {
                    const float f = __builtin_amdgcn_exp2f(-dl); l_reg *= f;
                    if (hi == 0) wsf[r32] = f;
#pragma unroll
                    for (int r = 0; r < 16; ++r) { const float fr_ = wsf[crow(r, hi)]; o[0][r] *= fr_; o[1][r] *= fr_; }
                }
            }
            float sacc = 0.f;
#pragma unroll
            for (int r = 0; r < 16; ++r) { p0[r] = __builtin_amdgcn_exp2f(p0[r]); p1[r] = __builtin_amdgcn_exp2f(p1[r]); sacc += p0[r] + p1[r]; }
            l_reg += sacc;
#pragma unroll
            for (int kk = 0; kk < 4; ++kk) { pw[0][kk] = cvt_pk_bf16(p0[2 * kk], p0[2 * kk + 1]); pw[1][kk] = cvt_pk_bf16(p0[8 + 2 * kk], p0[8 + 2 * kk + 1]);
                pw[2][kk] = cvt_pk_bf16(p1[2 * kk], p1[2 * kk + 1]); pw[3][kk] = cvt_pk_bf16(p1[8 + 2 * kk], p1[8 + 2 * kk + 1]); }
            if (g == 0) ATT_PV(pw, sv); else pend = true;
        }
        svp = sv; sv = (sv == 2) ? 0 : sv + 1;
    }
    if (pend) ATT_PV(pw, svp);
    l_reg = halfsum(l_reg);
    if (hi == 0) wsf[32 + r32] = l_reg;
    float rli[16];
#pragma unroll
    for (int r = 0; r < 16; ++r) rli[r] = __builtin_amdgcn_rcpf(wsf[32 + crow(r, hi)]);
    { LAS bf16_t* stg = (LAS bf16_t*)(shm3 + LDS_OST) + wid * 2048;
#pragma unroll
      for (int r = 0; r < 16; ++r) { const int orow = crow(r, hi);
#pragma unroll
          for (int d0 = 0; d0 < 2; ++d0) stg[orow * 64 + d0 * 32 + r32] = (bf16_t)(cvt_pk_bf16(o[d0][r] * rli[r], 0.f) & 0xffffu); }
      bf16_t* Ow = a.O + (long)(wid * 32) * a.ldo;
#pragma unroll
      for (int i = 0; i < 4; ++i) { const int row = i * 8 + (lane >> 3), ch = lane & 7; const u32x4 v = *(const LAS u32x4*)(stg + row * 64 + ch * 8); *(u32x4*)(Ow + (long)row * a.ldo + ch * 8) = v; } }
    asm volatile("s_waitcnt vmcnt(0) lgkmcnt(0)\n\ts_barrier" ::: "memory");
#undef ATT_DMA
#undef ATT_WAIT_BAR
#undef ATT_PV
}
}


#define XB_TMO      128
#define XB_XCNT(j)  (256  + 64 * (j))
#define XB_XSUB(j)  (1280 + 64 * (j))
#define XB_XGEN(j)  (2304 + 64 * (j))
#define XB_TOP      3328
#define XB_TOPGEN   3392
#define XCD_BAR_WORDS 3456
#define XL_CNT(j)   (3584 + 64 * (j))
#define XB_SPIN_CAP (1u << 22)
__device__ __forceinline__ unsigned xb_ld(unsigned* p)              { return __hip_atomic_load(p, __ATOMIC_RELAXED, __HIP_MEMORY_SCOPE_AGENT); }
__device__ __forceinline__ unsigned xb_add(unsigned* p, unsigned v) { return __hip_atomic_fetch_add(p, v, __ATOMIC_RELAXED, __HIP_MEMORY_SCOPE_AGENT); }
__device__ __forceinline__ unsigned xb_xcc_id() { return (unsigned)__builtin_amdgcn_s_getreg((3 << 11) | 20) & 0xFu; }
#define XB_SPIN(cond, bar) do { unsigned _sp = 0; while (cond) { __builtin_amdgcn_s_sleep(1); \
    if ((++_sp & 255u) == 0u) { if (xb_ld(&(bar)[XB_TMO])) break; if (_sp > XB_SPIN_CAP) { atomicAdd(&(bar)[XB_TMO], 1u); break; } } } } while (0)
struct XcdBarrier { unsigned* bar; unsigned x; volatile LAS unsigned* st; };
__device__ __forceinline__ XcdBarrier xcd_barrier_post(unsigned* bar, volatile LAS unsigned* st) {
    XcdBarrier b; b.bar = bar; b.x = xb_xcc_id(); b.st = st;
    if (threadIdx.x == 0) (void)xb_add(&bar[XB_XCNT(b.x)], 1u);
    return b;
}
__device__ __forceinline__ void xcd_barrier_complete(unsigned* bar, unsigned x, unsigned& nloc, unsigned& nx) {
    const unsigned G = gridDim.x * gridDim.y * gridDim.z;
    unsigned sum, cnt, mine, sp = 0u;
    for (;;) {
        sum = 0u; cnt = 0u; mine = 0u;
#pragma unroll
        for (unsigned j = 0; j < 16; ++j) { const unsigned c = xb_ld(&bar[XB_XCNT(j)]); sum += c; cnt += (c > 0u) ? 1u : 0u; mine = (j == x) ? c : mine; }
        if (sum == G) break;
        __builtin_amdgcn_s_sleep(1);
        if ((++sp & 255u) == 0u) { if (xb_ld(&bar[XB_TMO])) break; if (sp > XB_SPIN_CAP) { atomicAdd(&bar[XB_TMO], 1u); break; } }
    }
    nloc = mine > 0u ? mine : 1u; nx = cnt > 0u ? cnt : 1u;
}
__device__ __forceinline__ void xcd_barrier(const XcdBarrier& b) {
    asm volatile("s_waitcnt vmcnt(0)" ::: "memory");
    __syncthreads();
    if (threadIdx.x == 0) {
        unsigned* bar = b.bar;
        __builtin_amdgcn_s_waitcnt(0);
        unsigned nloc = b.st[0], nx = b.st[1];
        if (nloc == 0u) { xcd_barrier_complete(bar, b.x, nloc, nx); b.st[0] = nloc; b.st[1] = nx; }
        const unsigned old = xb_add(&bar[XB_XSUB(b.x)], 1u);
        const unsigned gen = old / nloc;
        if (old + 1u == (gen + 1u) * nloc) {
            __builtin_amdgcn_fence(__ATOMIC_RELEASE, "agent");
            asm volatile("s_waitcnt vmcnt(0)" ::: "memory");
            const unsigned og = xb_add(&bar[XB_TOP], 1u);
            const unsigned tg = og / nx;
            if (og + 1u == (tg + 1u) * nx) xb_add(&bar[XB_TOPGEN], 1u);
            else XB_SPIN(xb_ld(&bar[XB_TOPGEN]) == tg, bar);
            __builtin_amdgcn_fence(__ATOMIC_ACQUIRE, "agent");
            xb_add(&bar[XB_XGEN(b.x)], 1u);
            asm volatile("s_waitcnt vmcnt(0)" ::: "memory");
        } else {
            XB_SPIN(xb_ld(&bar[XB_XGEN(b.x)]) == gen, bar);
            __builtin_amdgcn_fence(__ATOMIC_ACQUIRE, "agent");
            asm volatile("s_waitcnt vmcnt(0)" ::: "memory");
        }
    }
    __syncthreads();
}

__device__ __forceinline__ void xcd_local_barrier(const XcdBarrier& b, unsigned nloc) {
    asm volatile("s_waitcnt vmcnt(0)" ::: "memory");
    __syncthreads();
    if (threadIdx.x == 0) {
        unsigned* bar = b.bar;
        __builtin_amdgcn_s_waitcnt(0);
        const unsigned lgen = b.st[5] + 1u; b.st[5] = lgen;
        (void)xb_add(&bar[XL_CNT(b.x)], 1u);
        const unsigned target = lgen * nloc;
        XB_SPIN(xb_ld(&bar[XL_CNT(b.x)]) < target, bar);
        __builtin_amdgcn_fence(__ATOMIC_ACQUIRE, "agent");
        asm volatile("s_waitcnt vmcnt(0)" ::: "memory");
    }
    __syncthreads();
}

struct Params { const float* in[25]; float* out; unsigned char* ws; int ph_lo, ph_hi; };
enum { I_XP = 0, I_XS, I_FFN_NORM, I_FFN_G, I_FFN_U, I_FFN_D, I_MIX_NORM, I_EV_IN, I_EV_CONV, I_Q_NORM, I_W_UQ, I_KV_NORM, I_W_UKV, I_EV_OUT,
       I_OD_IN, I_OD_CONV, I_OD_CONVB, I_LRU_WA, I_LRU_BA, I_LRU_WX, I_LRU_BX, I_LRU_LAM, I_SINK, I_OD_OUT, I_FINAL_NORM };

__device__ __forceinline__ int rope_perm(int j) { return j < 16 ? 2 * j : 2 * (j - 16) + 1; }

struct PrepJob { const float* W; const float* gain; bf16_t* WT; float scale; int N, K, mode, kb, nb; };
__device__ __forceinline__ void prep_load(const PrepJob& j, int lane, f32x4 (&v)[16]) {
    const int k0 = 64 * j.kb, n0 = 64 * j.nb, cq = (lane & 15) * 4, rq = lane >> 4;
    const bool colok = (n0 + cq) < j.N;
#pragma unroll
    for (int i = 0; i < 16; ++i) v[i] = colok ? *(const f32x4*)(j.W + (size_t)(k0 + 4 * i + rq) * j.N + n0 + cq) : (f32x4){0.f, 0.f, 0.f, 0.f};
}
__device__ __forceinline__ void prep_store(const PrepJob& j, int lane, const f32x4 (&v)[16], LAS float* scr) {
    const int k0 = 64 * j.kb, n0 = 64 * j.nb, cq = (lane & 15) * 4, rq = lane >> 4, mode = j.mode;
#pragma unroll
    for (int i = 0; i < 16; ++i) { LAS float* d = scr + (4 * i + rq) * 65 + cq; d[0] = v[i].x; d[1] = v[i].y; d[2] = v[i].z; d[3] = v[i].w; }
    asm volatile("s_waitcnt lgkmcnt(0)" ::: "memory");
    const int c = lane & 7;
    float g[8];
#pragma unroll
    for (int e = 0; e < 8; ++e) g[e] = (j.gain ? j.gain[k0 + 8 * c + e] : 1.0f) * j.scale;
#pragma unroll
    for (int jj = 0; jj < 8; ++jj) { const int n = (lane >> 3) + 8 * jj; const LAS float* sp = scr + (8 * c) * 65 + n;
        u32x4 o; o.x = cvt_pk_bf16(sp[0 * 65] * g[0], sp[1 * 65] * g[1]); o.y = cvt_pk_bf16(sp[2 * 65] * g[2], sp[3 * 65] * g[3]); o.z = cvt_pk_bf16(sp[4 * 65] * g[4], sp[5 * 65] * g[5]); o.w = cvt_pk_bf16(sp[6 * 65] * g[6], sp[7 * 65] * g[7]);
        const int ns = n0 + n; int row;
        if (mode == 0) row = ns;
        else if (mode == 1) row = (ns >> 7) * 256 + (ns & 127);
        else if (mode == 2) row = (ns >> 7) * 256 + 128 + (ns & 127);
        else if (mode == 3) { const int h = ns / 96, d = ns % 96; row = h * 96 + (d < 64 ? d : 64 + rope_perm(d - 64)); }
        else if (mode == 4) row = ns < 2176 ? ns : 2176 + rope_perm(ns - 2176);
        else row = ns < 512 ? ns : (ns < 1024 ? ns + 512 : (ns < 1536 ? ns - 512 : ns));
        if (ns < j.N) *(u32x4*)(j.WT + (size_t)row * j.K + k0 + 8 * c) = o; }
    asm volatile("s_waitcnt lgkmcnt(0)" ::: "memory");
}

__device__ __forceinline__ void norm_row(const float* xrow, bf16_t* orow, float* prow, int lane) {
    const f32x4* xr = (const f32x4*)xrow + lane;
    f32x4 v[4]; float s = 0.f;
#pragma unroll
    for (int j = 0; j < 4; ++j) { v[j] = xr[64 * j]; s += (v[j].x * v[j].x + v[j].y * v[j].y) + (v[j].z * v[j].z + v[j].w * v[j].w); }
    const float tot = wave_sum(s);
    if (lane < 16) prow[lane] = lane == 0 ? tot : 0.f;
    u32x2* o8 = (u32x2*)orow + lane;
#pragma unroll
    for (int j = 0; j < 4; ++j) { u32x2 w; w.x = cvt_pk_bf16(v[j].x, v[j].y); w.y = cvt_pk_bf16(v[j].z, v[j].w); o8[64 * j] = w; }
}
__device__ __forceinline__ void norm_phase(const float* src0, const float* src1, bf16_t* XN, float* part, int gw, int NGW, int lane) {
    for (int m = gw; m < T; m += NGW) norm_row(m < TP ? src0 + (size_t)m * DM : src1 + (size_t)(m - TP) * DM, XN + (size_t)m * DM, part + (size_t)m * 16, lane);
}
__device__ __forceinline__ float gelu_tanh(float x) { const float u = 0.7978845608028654f * (x + 0.044715f * x * x * x); const float e = __builtin_amdgcn_exp2f(2.0f * LOG2E * u); const float th = 1.0f - 2.0f * __builtin_amdgcn_rcpf(e + 1.0f); return 0.5f * x * (1.0f + th); }
__device__ __forceinline__ void unpack8(const u32x4 w, float (&f)[8]) { f[0] = bf_lo(w.x); f[1] = bf_hi(w.x); f[2] = bf_lo(w.y); f[3] = bf_hi(w.y); f[4] = bf_lo(w.z); f[5] = bf_hi(w.z); f[6] = bf_lo(w.w); f[7] = bf_hi(w.w); }
__device__ __forceinline__ u32x4 pack8(const float (&f)[8]) { u32x4 w; w.x = cvt_pk_bf16(f[0], f[1]); w.y = cvt_pk_bf16(f[2], f[3]); w.z = cvt_pk_bf16(f[4], f[5]); w.w = cvt_pk_bf16(f[6], f[7]); return w; }

__global__ void __launch_bounds__(NTHREADS) mk_fwd(Params P) {
    extern __shared__ __attribute__((aligned(16))) unsigned char lds_raw[];
    LAS unsigned char* lds = (LAS unsigned char*)lds_raw;
    cg::grid_group grid = cg::this_grid();
    const int G = gridDim.x, bx = blockIdx.x;
    const int NGW = G * 8, NGT = G * NTHREADS;
    unsigned char* ws = P.ws;
    float* out = P.out;
    bf16_t* Wb = (bf16_t*)(ws + WS_W);
    bf16_t* XN = (bf16_t*)(ws + WS_XN);
    unsigned char* big = ws + WS_BIG;
    float* rope_tab = (float*)(ws + WS_ROPE);
    float* aggP = (float*)(ws + WS_AGG); float* aggH = aggP + 512 * 1024; float* aggC = aggH + 512 * 1024;
    float* part = aggP;
    const int lo = P.ph_lo, hi = P.ph_hi;
    int ph = 0;
    volatile LAS unsigned* bst = (volatile LAS unsigned*)(lds + LDS_BYTES - 64);
    if (threadIdx.x < 8) bst[threadIdx.x] = 0u;
    __syncthreads();
    XcdBarrier xbar; xbar.bar = (unsigned*)(ws + WS_BAR); xbar.x = xb_xcc_id(); xbar.st = bst;
    if (threadIdx.x == 0) { bst[4] = xb_add(&xbar.bar[XB_XCNT(xbar.x)], 1u);
        bst[2] = (unsigned)bx; bst[3] = (unsigned)((G % 8 == 0) ? (bx % 8) * (G / 8) + bx / 8 : bx); }
    __syncthreads();
#define BEGIN_PH if (ph >= lo && ph < hi) { int tid = threadIdx.x; asm volatile("" : "+v"(tid)); const int lane = tid & 63, wave = __builtin_amdgcn_readfirstlane(tid >> 6); \
        const int cidx = __builtin_amdgcn_readfirstlane((int)bst[2]); const unsigned pw_ = (unsigned)__builtin_amdgcn_readfirstlane((int)bst[3]); const int vcu = (int)(pw_ & 0xffffu); const bool xl_ok = (pw_ >> 16) != 0u; \
        const int gw = vcu * 8 + wave, gt = bx * NTHREADS + tid; (void)lane; (void)gw; (void)gt; (void)cidx; (void)xl_ok;
#define END_PH_X(loc_) if (ph + 1 < hi) { if (ph == 0) grid.sync(); else if (xl_ok && (loc_)) xcd_local_barrier(xbar, (unsigned)(G / 8)); else xcd_barrier(xbar); } } ++ph;
#define END_PH   END_PH_X(false)

    BEGIN_PH
    {
        LAS float* scr = (LAS float*)(lds + wave * 16640);
        constexpr int N_FFN = 24 * 704, N_EV = 2 * 952, N_OD = 2 * 704, N_ALL = N_FFN + N_EV + N_OD;
#define PREP_DECODE(it_, J_) do { const int it = (it_); \
            const float* W; int K, N, mode; const float* gain = nullptr; float scale = 1.f; bf16_t* WT; int r; \
            if (it < N_FFN) { const int j = it / 704; r = it % 704; const int f = j / 3, w = j % 3; \
                if (w < 2) { W = P.in[w == 0 ? I_FFN_G : I_FFN_U] + (size_t)f * DM * FF; K = DM; N = FF; gain = P.in[I_FFN_NORM] + f * DM; mode = 1 + w; WT = Wb + W_GU + f * W_GU_SZ; } \
                else { W = P.in[I_FFN_D] + (size_t)f * FF * DM; K = FF; N = DM; mode = 0; WT = Wb + W_DN + f * W_DN_SZ; } } \
            else if (it < N_FFN + N_EV) { const int i2 = it - N_FFN; const int jj = i2 / 952; r = i2 % 952; \
                if (r < 560) { W = P.in[I_EV_IN] + (size_t)jj * DM * EV_IN; K = DM; N = EV_IN; gain = P.in[I_MIX_NORM] + (2 * jj) * DM; mode = 4; WT = Wb + W_EVIN + jj * W_EVIN_SZ; } \
                else if (r < 632) { r -= 560; W = P.in[I_W_UQ] + (size_t)jj * 384 * 768; K = 384; N = 768; gain = P.in[I_Q_NORM] + jj * 384; mode = 3; scale = 0.10206207261596575f * LOG2E; WT = Wb + W_UQ + jj * W_UQ_SZ; } \
                else if (r < 696) { r -= 632; W = P.in[I_W_UKV] + (size_t)jj * 256 * 1024; K = 256; N = 1024; gain = P.in[I_KV_NORM] + jj * 256; mode = 0; WT = Wb + W_UKV + jj * W_UKV_SZ; } \
                else { r -= 696; W = P.in[I_EV_OUT] + (size_t)jj * DM * DM; K = DM; N = DM; mode = 0; WT = Wb + W_EVOUT + jj * W_SQ_SZ; } } \
            else { const int i2 = it - N_FFN - N_EV; const int jj = i2 / 704; r = i2 % 704; \
                if (r < 448) { W = P.in[I_OD_IN] + (size_t)jj * DM * OD_IN; K = DM; N = OD_IN; gain = P.in[I_MIX_NORM] + (2 * jj + 1) * DM; mode = 5; WT = Wb + W_ODIN + jj * W_ODIN_SZ; } \
                else { r -= 448; W = P.in[I_OD_OUT] + (size_t)jj * DM * DM; K = DM; N = DM; mode = 0; WT = Wb + W_ODOUT + jj * W_SQ_SZ; } } \
            const int nblk = (N + 63) / 64, kb = r / nblk, nb = r % nblk; \
            if (mode == 5 && nb >= 16 && nb < 24) scale = 0.125f * LOG2E;     \
            (J_) = PrepJob{W, gain, WT, scale, N, K, mode, kb, nb}; } while (0)
        for (int it0 = gw; it0 < N_ALL; it0 += 2 * NGW) {
            PrepJob ja, jb; f32x4 va[16], vb[16]; const bool hb = it0 + NGW < N_ALL;
            PREP_DECODE(it0, ja); prep_load(ja, lane, va);
            if (hb) { PREP_DECODE(it0 + NGW, jb); prep_load(jb, lane, vb); }
            prep_store(ja, lane, va, scr);
            if (hb) prep_store(jb, lane, vb, scr);
        }
#undef PREP_DECODE
        for (int i = gt; i < 2 * 96 * 1024 / 8; i += NGT) { const int jj = i / (96 * 128), rr = i % (96 * 128); *(u32x4*)(Wb + W_EVIN + jj * W_EVIN_SZ + (size_t)EV_IN * 1024 + (size_t)rr * 8) = (u32x4){0u, 0u, 0u, 0u}; }
        for (int i = gt; i < 2 * 2048 * 64; i += NGT) { const int jj = i / (2048 * 64), rr = (i / 64) % 2048, cc = (i % 64) * 8;
            const int unit = rr >> 8, gate = (rr >> 7) & 1, c = (unit & 3) * 128 + (rr & 127), dir = unit >> 2, nb = c >> 6, d = c & 63;
            u32x4 w = (u32x4){0u, 0u, 0u, 0u};
            if ((cc >> 6) == nb) { const float* src = P.in[gate ? I_LRU_WX : I_LRU_WA] + ((((size_t)jj * 2 + dir) * 8 + nb) * 64 + (cc & 63)) * 64 + d; float f[8];
#pragma unroll
                for (int j = 0; j < 8; ++j) f[j] = src[j * 64];
                w = pack8(f); }
            *(u32x4*)(Wb + W_LRU + jj * W_LRU_SZ + (size_t)rr * 512 + cc) = w; }
        for (int i = gt; i < 8192 * 16; i += NGT) { const int pos = i >> 4, fi = i & 15;
            const double inv = exp2(-(double)fi * (13.287712379549449 / 16.0));
            const double rev = (double)pos * inv * 0.15915494309189535; const float fr = (float)(rev - rint(rev));
            rope_tab[2 * i] = __builtin_amdgcn_cosf(fr); rope_tab[2 * i + 1] = __builtin_amdgcn_sinf(fr); }
        norm_phase(P.in[I_XP], P.in[I_XS], XN, part, gw, NGW, lane);
    }
    END_PH
    if (hi - lo > 1 && (G % 8) == 0) {
        bool ok = true;
#pragma unroll
        for (unsigned j = 0; j < 16; ++j) { const unsigned c = xb_ld(&xbar.bar[XB_XCNT(j)]); ok = ok && (c == (j < 8 ? (unsigned)(G / 8) : 0u)); }
        if (__builtin_amdgcn_readfirstlane((int)ok) != 0) {
            if (threadIdx.x == 0) { const unsigned rk = bst[4]; bst[2] = rk * 8u + xbar.x; bst[3] = (xbar.x * (unsigned)(G / 8) + rk) | (1u << 16); }
            __syncthreads();
        }
    }

#pragma unroll 1
    for (int l = 0; l < 4; ++l) {
        const int jj = l >> 1;
#pragma unroll 1
        for (int sub = 0; sub < 3; ++sub) {
            if (sub != 1) {
                const int f = l * 2 + (sub >> 1);
                BEGIN_PH { pg8::EpiSwiglu E{(bf16_t*)(big + B_ACT), part}; run_gemm<pg8::EpiSwiglu, true>(lds, XN, DM, Wb + W_GU + f * W_GU_SZ, 5632, DM, E, cidx); } END_PH_X(true)
                BEGIN_PH { pg8::EpiRes E{XN, part, 0.5f};
                    run_gemm<pg8::EpiRes, true>(lds, (const bf16_t*)(big + B_ACT), FF, Wb + W_DN + f * W_DN_SZ, DM, FF, E, cidx); } END_PH_X(sub == 0 || l < 3)
            } else if ((l & 1) == 0) {
                bf16_t* Z = (bf16_t*)(big + B_Z); bf16_t* Q = (bf16_t*)((unsigned char*)out + O_Q); bf16_t* KPE = (bf16_t*)((unsigned char*)out + O_KPE); bf16_t* KV = (bf16_t*)out;
                BEGIN_PH { pg8::EpiStore<true> E{Z, ZLD, part}; run_gemm<pg8::EpiStore<true>, true>(lds, XN, DM, Wb + W_EVIN + jj * W_EVIN_SZ, EV_INP, DM, E, cidx); } END_PH
                BEGIN_PH {
                    const float* cw = P.in[I_EV_CONV] + jj * 3 * 512;
                    float w0[8], w1[8], w2[8];
#pragma unroll
                    for (int j = 0; j < 8; ++j) { w0[j] = cw[lane * 8 + j]; w1[j] = cw[512 + lane * 8 + j]; w2[j] = cw[1024 + lane * 8 + j]; }
                    const int CH = (T + NGW - 1) / NGW; const int t0 = gw * CH, t1 = (t0 + CH < T) ? t0 + CH : T;
                    if (t0 < t1) {
                        float gp[8], gc[8], ta[8], tb[8];
                        { const bf16_t* zr = Z + (size_t)t0 * ZLD; unpack8(*(const u32x4*)(zr + 512 + lane * 8), ta); unpack8(*(const u32x4*)(zr + 1024 + lane * 8), tb);
#pragma unroll
                          for (int j = 0; j < 8; ++j) gc[j] = ta[j] * tb[j];
                          if (t0 > 0) { unpack8(*(const u32x4*)(zr - ZLD + 512 + lane * 8), ta); unpack8(*(const u32x4*)(zr - ZLD + 1024 + lane * 8), tb); }
#pragma unroll
                          for (int j = 0; j < 8; ++j) gp[j] = t0 > 0 ? ta[j] * tb[j] : 0.f; }
                        u32x4 rbg, rql, rkl, rcn, rxn; unsigned rkr;
#define EV_PREFETCH(t_) do { const bf16_t* z_ = Z + (size_t)(t_) * ZLD; rbg = *(const u32x4*)(z_ + lane * 8); rql = *(const u32x4*)(z_ + 1536 + (lane < 48 ? lane : 0) * 8); \
                            rkl = *(const u32x4*)(z_ + 1920 + (lane & 31) * 8); rkr = *(const unsigned*)(z_ + 2176 + (lane & 15) * 2); \
                            if ((t_) + 1 < T) { rcn = *(const u32x4*)(z_ + ZLD + 512 + lane * 8); rxn = *(const u32x4*)(z_ + ZLD + 1024 + lane * 8); } else { rcn = (u32x4){0u, 0u, 0u, 0u}; rxn = rcn; } } while (0)
                        EV_PREFETCH(t0);
                        for (int m = t0; m < t1; ++m) {
                            const int S = m < TP ? 8192 : 4096, pos = m & (S - 1);
                            bf16_t* zr = Z + (size_t)m * ZLD;
                            const u32x4 cbg = rbg, cql = rql, ckl = rkl, ccn = rcn, cxn = rxn; const unsigned krw = rkr;
                            if (m + 1 < t1) EV_PREFETCH(m + 1);
                            float bg[8], gn[8], acc8[8];
                            unpack8(cbg, bg); unpack8(ccn, ta); unpack8(cxn, tb);
#pragma unroll
                            for (int j = 0; j < 8; ++j) gn[j] = ta[j] * tb[j];
                            const float fp = pos > 0 ? 1.f : 0.f, fn = pos < S - 1 ? 1.f : 0.f;
#pragma unroll
                            for (int j = 0; j < 8; ++j) acc8[j] = bg[j] * (w1[j] * gc[j] + fp * w0[j] * gp[j] + fn * w2[j] * gn[j]);
                            float ql[8], kl[8]; float sq = 0.f, sk = 0.f;
                            unpack8(cql, ql); unpack8(ckl, kl);
#pragma unroll
                            for (int j = 0; j < 8; ++j) { sq += ql[j] * ql[j]; sk += kl[j] * kl[j]; }
                            if (lane >= 48) sq = 0.f;
                            if (lane >= 32) sk = 0.f;
                            sq = wave_sum(sq); sk = wave_sum(sk);
                            const float rq = rsqrtf(sq * (1.f / 384.f) + EPS), rk = rsqrtf(sk * (1.f / 256.f) + EPS);
                            *(u32x4*)(zr + lane * 8) = pack8(acc8);
                            if (lane < 48) {
#pragma unroll
                                for (int j = 0; j < 8; ++j) ql[j] *= rq;
                                *(u32x4*)(zr + 1536 + lane * 8) = pack8(ql); }
                            if (lane < 32) {
#pragma unroll
                                for (int j = 0; j < 8; ++j) kl[j] *= rk;
                                *(u32x4*)(zr + 1920 + lane * 8) = pack8(kl); }
                            if (lane < 16) { const float x1 = bf_lo(krw), x2 = bf_hi(krw); const f32x2 cs = *(const f32x2*)(rope_tab + ((size_t)pos * 16 + lane) * 2);
                                *(unsigned*)(KPE + (size_t)m * 32 + lane * 2) = cvt_pk_bf16(x1 * cs.x - x2 * cs.y, x1 * cs.y + x2 * cs.x); }
#pragma unroll
                            for (int j = 0; j < 8; ++j) { gp[j] = gc[j]; gc[j] = gn[j]; }
                        }
#undef EV_PREFETCH
                    }
                } END_PH_X(true)
                BEGIN_PH {
                    { pg8::EpiQRope E{Q, rope_tab}; run_gemm<pg8::EpiQRope, true>(lds, Z + 1536, ZLD, Wb + W_UQ + jj * W_UQ_SZ, 768, 384, E, cidx); }
                    { pg8::EpiStore<false> E{KV, 1024, nullptr}; run_gemm<pg8::EpiStore<false>, true>(lds, Z + 1920, ZLD, Wb + W_UKV + jj * W_UKV_SZ, 1024, 256, E, cidx); }
                } END_PH
                BEGIN_PH {
                    for (int u = vcu; u < 1024; u += G) {
                        int seq0, S, h, qb;
                        if (u < 512) { const int sh = u >> 5; qb = u & 31; seq0 = (sh >> 3) * 8192; S = 8192; h = sh & 7; }
                        else { const int u2 = u - 512, sh = u2 >> 4; qb = u2 & 15; seq0 = TP + (sh >> 3) * 4096; S = 4096; h = sh & 7; }
                        att::Unit a; const size_t r0 = (size_t)seq0 + qb * 256;
                        a.Q = Q + r0 * 768 + h * 96; a.ldq = 768; a.K = KV + (size_t)seq0 * 1024 + h * 128; a.ldk = 1024; a.KPE = KPE + (size_t)seq0 * 32;
                        a.V = KV + (size_t)seq0 * 1024 + h * 128 + 64; a.ldv = 1024; a.O = Z + r0 * ZLD + 512 + h * 64; a.ldo = ZLD;
                        a.t_lo = 0; a.t_hi = S / 64; a.qpos0 = qb * 256; a.slope2 = 0.f; a.sink2 = 0.f;
                        att::attn_unit<0>(a, (char*)lds_raw);
                    }
                } END_PH
                BEGIN_PH { pg8::EpiRes E{XN, part, 1.0f}; run_gemm<pg8::EpiRes, true>(lds, Z, ZLD, Wb + W_EVOUT + jj * W_SQ_SZ, DM, DM, E, cidx); } END_PH_X(true)
            } else {
                bf16_t* Z2 = (bf16_t*)(big + B_Z2); bf16_t* XC = (bf16_t*)(big + B_XC); bf16_t* U = (bf16_t*)((unsigned char*)out + O_U); bf16_t* LA = (bf16_t*)out;
                BEGIN_PH { pg8::EpiStore<true> E{Z2, ZLD, part}; run_gemm<pg8::EpiStore<true>, true>(lds, XN, DM, Wb + W_ODIN + jj * W_ODIN_SZ, OD_IN, DM, E, cidx); } END_PH
                BEGIN_PH {
                    const float* cw = P.in[I_OD_CONV] + jj * 4 * 512; const float* cb = P.in[I_OD_CONVB] + jj * 512;
                    float w4[4][8], bb[8];
#pragma unroll
                    for (int j = 0; j < 8; ++j) { bb[j] = cb[lane * 8 + j];
#pragma unroll
                        for (int k = 0; k < 4; ++k) w4[k][j] = cw[k * 512 + lane * 8 + j]; }
                    const int CH = (T + NGW - 1) / NGW; const int t0 = gw * CH, t1 = (t0 + CH < T) ? t0 + CH : T;
                    if (t0 < t1) {
                        const u32x4 zero4 = (u32x4){0u, 0u, 0u, 0u};
                        const bf16_t* z0 = Z2 + (size_t)t0 * ZLD + lane * 8;
                        u32x4 r0 = t0 >= 2 ? *(const u32x4*)(z0 - 2 * ZLD) : zero4, r1 = t0 >= 1 ? *(const u32x4*)(z0 - ZLD) : zero4, r2 = *(const u32x4*)z0;
                        u32x4 r3 = (t0 + 1 < T) ? *(const u32x4*)(z0 + ZLD) : zero4;
                        for (int m = t0; m < t1; ++m) {
                            const int S = m < TP ? 8192 : 4096, pos = m & (S - 1);
                            const u32x4 nx = (m + 2 < T) ? *(const u32x4*)(Z2 + (size_t)(m + 2) * ZLD + lane * 8) : zero4;
                            float x0[8], x1[8], x2[8], x3[8], a8[8];
                            unpack8(r0, x0); unpack8(r1, x1); unpack8(r2, x2); unpack8(r3, x3);
                            const float f0 = pos >= 2 ? 1.f : 0.f, f1 = pos >= 1 ? 1.f : 0.f, f3 = pos < S - 1 ? 1.f : 0.f;
#pragma unroll
                            for (int j = 0; j < 8; ++j) a8[j] = bb[j] + w4[2][j] * x2[j] + f0 * w4[0][j] * x0[j] + f1 * w4[1][j] * x1[j] + f3 * w4[3][j] * x3[j];
                            *(u32x4*)(XC + (size_t)m * 512 + lane * 8) = pack8(a8);
                            r0 = r1; r1 = r2; r2 = r3; r3 = nx;
                        }
                    }
                } END_PH_X(true)
                BEGIN_PH { pg8::EpiLru E{LA, U, XC, P.in[I_LRU_BA] + jj * 1024, P.in[I_LRU_BX] + jj * 1024, P.in[I_LRU_LAM] + jj * 1024};
                    run_gemm<pg8::EpiLru, true>(lds, XC, 512, Wb + W_LRU + jj * W_LRU_SZ, 2048, 512, E, cidx, 128); } END_PH
                BEGIN_PH {
                    for (int it = gt; it < 512 * 512; it += NGT) { const int ch = it >> 9, cp = it & 511, col = cp * 2; const bool bwd = col >= 512;
                        const size_t base = (size_t)ch * 64 * 1024 + col;
                        float h0 = 0.f, h1 = 0.f, s0 = 0.f, s1 = 0.f;
#pragma unroll 8
                        for (int i = 0; i < 64; ++i) { const int tt = bwd ? 63 - i : i; const unsigned lw = *(const unsigned*)(LA + base + (size_t)tt * 1024), uw = *(const unsigned*)(U + base + (size_t)tt * 1024);
                            const float l0 = bf_lo(lw), l1 = bf_hi(lw); s0 += l0; s1 += l1;
                            h0 = __builtin_amdgcn_exp2f(l0) * h0 + bf_lo(uw); h1 = __builtin_amdgcn_exp2f(l1) * h1 + bf_hi(uw); }
                        *(f32x2*)(aggP + (size_t)ch * 1024 + col) = (f32x2){__builtin_amdgcn_exp2f(s0), __builtin_amdgcn_exp2f(s1)};
                        *(f32x2*)(aggH + (size_t)ch * 1024 + col) = (f32x2){h0, h1}; }
                } END_PH
                BEGIN_PH {
                    for (int it = gt; it < 6 * 1024; it += NGT) { const int sq = it >> 10, col = it & 1023; const bool bwd = col >= 512;
                        const int c0 = sq < 2 ? sq * 128 : 256 + (sq - 2) * 64, nc = sq < 2 ? 128 : 64;
                        float c = 0.f;
                        for (int i0 = 0; i0 < nc; i0 += 8) { float p[8], hh[8];
#pragma unroll
                            for (int j = 0; j < 8; ++j) { const int ch = c0 + (bwd ? nc - 1 - (i0 + j) : i0 + j); p[j] = aggP[(size_t)ch * 1024 + col]; hh[j] = aggH[(size_t)ch * 1024 + col]; }
#pragma unroll
                            for (int j = 0; j < 8; ++j) { const int ch = c0 + (bwd ? nc - 1 - (i0 + j) : i0 + j); aggC[(size_t)ch * 1024 + col] = c; c = p[j] * c + hh[j]; } }
                    }
                } END_PH
                BEGIN_PH {
                    for (int it = gt; it < 512 * 256; it += NGT) { const int ch = it >> 8, cp = it & 255, col = cp * 2;
                        const size_t base = (size_t)ch * 64 * 1024 + col;
                        unsigned hfp[64];
                        { const f32x2 cf = *(const f32x2*)(aggC + (size_t)ch * 1024 + col); float h0 = cf.x, h1 = cf.y;
#pragma unroll
                          for (int b = 0; b < 8; ++b) { unsigned lw[8], uw[8];
#pragma unroll
                              for (int j = 0; j < 8; ++j) { const size_t ix = base + (size_t)(b * 8 + j) * 1024; lw[j] = *(const unsigned*)(LA + ix); uw[j] = *(const unsigned*)(U + ix); }
#pragma unroll
                              for (int j = 0; j < 8; ++j) { h0 = __builtin_amdgcn_exp2f(bf_lo(lw[j])) * h0 + bf_lo(uw[j]); h1 = __builtin_amdgcn_exp2f(bf_hi(lw[j])) * h1 + bf_hi(uw[j]); hfp[b * 8 + j] = cvt_pk_bf16(h0, h1); } } }
                        { const f32x2 cf = *(const f32x2*)(aggC + (size_t)ch * 1024 + 512 + col); float h0 = cf.x, h1 = cf.y;
#pragma unroll
                          for (int b = 7; b >= 0; --b) { unsigned lw[8], uw[8], gwd[8];
#pragma unroll
                              for (int j = 0; j < 8; ++j) { const size_t ix = base + (size_t)(b * 8 + j) * 1024 + 512; lw[j] = *(const unsigned*)(LA + ix); uw[j] = *(const unsigned*)(U + ix);
                                  gwd[j] = *(const unsigned*)(Z2 + (size_t)(ch * 64 + b * 8 + j) * ZLD + col + 1024); }
#pragma unroll
                              for (int j = 7; j >= 0; --j) { h0 = __builtin_amdgcn_exp2f(bf_lo(lw[j])) * h0 + bf_lo(uw[j]); h1 = __builtin_amdgcn_exp2f(bf_hi(lw[j])) * h1 + bf_hi(uw[j]);
                                  const unsigned hf = hfp[b * 8 + j];
                                  *(unsigned*)(Z2 + (size_t)(ch * 64 + b * 8 + j) * ZLD + col) = cvt_pk_bf16(gelu_tanh(bf_lo(gwd[j])) * (bf_lo(hf) + h0), gelu_tanh(bf_hi(gwd[j])) * (bf_hi(hf) + h1)); } } }
                    }
                    for (int u = vcu; u < 1024; u += G) { const int rb = u >> 3, h = u & 7; const size_t r0 = (size_t)rb * 256;
                        const int S = r0 < TP ? 8192 : 4096; const int qpos0 = (int)(r0 & (size_t)(S - 1)); const size_t seq0 = r0 - qpos0;
                        att::Unit a; a.Q = Z2 + r0 * ZLD + 512 + h * 64; a.ldq = ZLD; a.K = Z2 + seq0 * ZLD + 1536 + (h >> 2) * 64; a.ldk = ZLD; a.KPE = nullptr;
                        a.V = Z2 + seq0 * ZLD + 1664 + (h >> 2) * 64; a.ldv = ZLD; a.O = Z2 + r0 * ZLD + 512 + h * 64; a.ldo = ZLD;
                        a.t_lo = max(0, qpos0 / 64 - 2); a.t_hi = min(S / 64, qpos0 / 64 + 6); a.qpos0 = qpos0;
                        a.slope2 = exp2f(-(float)(h + 1)) * LOG2E; a.sink2 = P.in[I_SINK][jj * 8 + h] * LOG2E;
                        att::attn_unit<1>(a, (char*)lds_raw);
                    }
                } END_PH
                BEGIN_PH { pg8::EpiRes E{XN, part, 1.0f}; run_gemm<pg8::EpiRes, true>(lds, Z2, ZLD, Wb + W_ODOUT + jj * W_SQ_SZ, DM, DM, E, cidx); } END_PH_X(true)
            }
        }
    }
    BEGIN_PH {
        const float* gn = P.in[I_FINAL_NORM];
        f32x4 g4[4];
#pragma unroll
        for (int j = 0; j < 4; ++j) g4[j] = *((const f32x4*)gn + lane + 64 * j);
        for (int m = gw; m < T; m += NGW) { const u32x2* xr = (const u32x2*)(XN + (size_t)m * DM) + lane; f32x4 v[4]; float s = 0.f;
#pragma unroll
            for (int j = 0; j < 4; ++j) { const u32x2 w = xr[64 * j]; v[j] = (f32x4){bf_lo(w.x), bf_hi(w.x), bf_lo(w.y), bf_hi(w.y)}; s += (v[j].x * v[j].x + v[j].y * v[j].y) + (v[j].z * v[j].z + v[j].w * v[j].w); }
            const float rstd = rsqrtf(wave_sum(s) * (1.f / DM) + EPS);
            f32x4* orow = (f32x4*)(out + (size_t)m * DM) + lane;
#pragma unroll
            for (int j = 0; j < 4; ++j) orow[64 * j] = v[j] * rstd * g4[j]; }
    } END_PH
#undef BEGIN_PH
#undef END_PH
#undef END_PH_X
}

constexpr int N_PHASES = 1 + 4 * (2 + 2) + 2 * 5 + 2 * 7 + 1;

extern "C" void kernel_launch(void* const* d_in, const int* in_sizes, int n_in, void* d_out, int out_size, void* d_ws, size_t ws_size, hipStream_t stream) {
    static int grid = 0;
    if (grid == 0) {
        if (n_in != 25 || out_size != T * DM || ws_size < WS_END) { fprintf(stderr, "kernel_launch: unexpected sizes n_in %d out %d ws %zu\n", n_in, out_size, ws_size); grid = -1; return; }
        int dev = 0, cus = 0, per_cu = 0;
        hipGetDevice(&dev); hipDeviceGetAttribute(&cus, hipDeviceAttributeMultiprocessorCount, dev);
        hipFuncSetAttribute((const void*)mk_fwd, hipFuncAttributeMaxDynamicSharedMemorySize, LDS_BYTES);
        hipOccupancyMaxActiveBlocksPerMultiprocessor(&per_cu, (const void*)mk_fwd, NTHREADS, LDS_BYTES);
        if (per_cu < 1) per_cu = 1;
        grid = cus * per_cu;
        (void)hipGetLastError();
    }
    if (grid < 0) return;
    Params p{};
    for (int i = 0; i < 25; ++i) p.in[i] = (const float*)d_in[i];
    p.out = (float*)d_out; p.ws = (unsigned char*)d_ws;
    (void)hipMemsetAsync((unsigned char*)d_ws + WS_BAR, 0, BAR_BYTES, stream);
#if MK_MULTI
    for (int ph = 0; ph < N_PHASES; ++ph) { p.ph_lo = ph; p.ph_hi = ph + 1; hipLaunchKernelGGL(mk_fwd, dim3(grid), dim3(NTHREADS), LDS_BYTES, stream, p); }
#else
    p.ph_lo = 0; p.ph_hi = N_PHASES;
    void* args[] = {&p};
    hipError_t e = hipLaunchCooperativeKernel((const void*)mk_fwd, dim3(grid), dim3(NTHREADS), args, LDS_BYTES, stream);
    if (e != hipSuccess) fprintf(stderr, "cooperative launch failed: %s (grid %d)\n", hipGetErrorString(e), grid);
#endif
}
```

```cpp
#include <hip/hip_runtime.h>
#include <hip/hip_cooperative_groups.h>
#include <cstdio>
#include <cstdint>
namespace cg = cooperative_groups;

#ifndef MK_MULTI
#define MK_MULTI 0
#endif

#define LAS __attribute__((address_space(3)))
typedef unsigned short bf16_t;
typedef short bf16x8 __attribute__((ext_vector_type(8)));
typedef short s16x4 __attribute__((ext_vector_type(4)));
typedef float f32x2 __attribute__((ext_vector_type(2)));
typedef float f32x4 __attribute__((ext_vector_type(4)));
typedef float f32x16 __attribute__((ext_vector_type(16)));
typedef unsigned u32x2 __attribute__((ext_vector_type(2)));
typedef unsigned u32x4 __attribute__((ext_vector_type(4)));

constexpr int T = 32768, TP = 16384, DM = 1024, FF = 2816;
constexpr int EV_IN = 2208, EV_INP = 2304, OD_IN = 1792;
constexpr float LOG2E = 1.4426950408889634f;
constexpr float EPS = 1e-6f;

constexpr size_t MiB = 1u << 20;
constexpr size_t WS_ROPE = 0, WS_AGG = 1 * MiB, WS_BAR = 7 * MiB, BAR_BYTES = 32768, WS_W = 7 * MiB + 65536, WS_XN = 170 * MiB, WS_BIG = 234 * MiB, WS_END = 442 * MiB;
constexpr size_t W_GU = 0, W_GU_SZ = (size_t)5632 * 1024;
constexpr size_t W_DN = W_GU + 8 * W_GU_SZ, W_DN_SZ = (size_t)1024 * 2816;
constexpr size_t W_EVIN = W_DN + 8 * W_DN_SZ, W_EVIN_SZ = (size_t)EV_INP * 1024;
constexpr size_t W_UQ = W_EVIN + 2 * W_EVIN_SZ, W_UQ_SZ = (size_t)768 * 384;
constexpr size_t W_UKV = W_UQ + 2 * W_UQ_SZ, W_UKV_SZ = (size_t)1024 * 256;
constexpr size_t W_EVOUT = W_UKV + 2 * W_UKV_SZ, W_SQ_SZ = (size_t)1024 * 1024;
constexpr size_t W_ODIN = W_EVOUT + 2 * W_SQ_SZ, W_ODIN_SZ = (size_t)OD_IN * 1024;
constexpr size_t W_LRU = W_ODIN + 2 * W_ODIN_SZ, W_LRU_SZ = (size_t)2048 * 512;
constexpr size_t W_ODOUT = W_LRU + 2 * W_LRU_SZ;
constexpr size_t W_TOTAL = W_ODOUT + 2 * W_SQ_SZ;
static_assert(WS_W + W_TOTAL * 2 <= WS_XN, "weights fit");
constexpr size_t B_ACT = 0;
constexpr int ZLD = 2816;
constexpr size_t B_Z = 0, O_Q = 64 * MiB, O_KPE = 112 * MiB;
constexpr size_t B_Z2 = 0, B_XC = 176 * MiB, O_U = 64 * MiB;

constexpr int LDS_BYTES = 147456;
constexpr int NTHREADS = 512;

__device__ __forceinline__ unsigned cvt_pk_bf16(float lo, float hi) { unsigned r; asm volatile("v_cvt_pk_bf16_f32 %0, %1, %2" : "=v"(r) : "v"(lo), "v"(hi)); return r; }
__device__ __forceinline__ float bf_lo(unsigned w) { return __uint_as_float(w << 16); }
__device__ __forceinline__ float bf_hi(unsigned w) { return __uint_as_float(w & 0xffff0000u); }
__device__ __forceinline__ float bf2f(bf16_t b) { return __uint_as_float((unsigned)b << 16); }
template <int O> __device__ __forceinline__ float swz_xor(float v) { return __builtin_bit_cast(float, __builtin_amdgcn_ds_swizzle(__builtin_bit_cast(int, v), 0x1F | (O << 10))); }
__device__ __forceinline__ float wave_sum(float v) {
    v += swz_xor<1>(v); v += swz_xor<2>(v); v += swz_xor<4>(v); v += swz_xor<8>(v); v += swz_xor<16>(v);
    auto rr = __builtin_amdgcn_permlane32_swap(__float_as_uint(v), __float_as_uint(v), false, false);
    return __uint_as_float(rr[0]) + __uint_as_float(rr[1]);
}
__device__ __forceinline__ float fq_sum(float v) {
    v += swz_xor<16>(v);
    auto rr = __builtin_amdgcn_permlane32_swap(__float_as_uint(v), __float_as_uint(v), false, false);
    return __uint_as_float(rr[0]) + __uint_as_float(rr[1]);
}
__device__ __forceinline__ float row_rstd(const float* part, int row, int fq) {
    const f32x4 p = *(const f32x4*)(part + (size_t)row * 16 + 4 * fq);
    return rsqrtf(fq_sum((p.x + p.y) + (p.z + p.w)) * (1.f / DM) + EPS);
}
__device__ __forceinline__ float sigmoidf_(float x) { return __builtin_amdgcn_rcpf(1.0f + __builtin_amdgcn_exp2f(-x * LOG2E)); }

namespace pg8 {
constexpr int BM = 256, BK = 64, HALF = 128, HTB = HALF * BK * 2, STAGE_BYTES = 8 * HTB, NXCD = 8, WGM = 8;
__host__ __device__ __forceinline__ int lds_byte(int r, int c) { const int st = (r >> 4) * 2 + (c >> 5), rr = r & 15, cc = c & 31, ob = rr * 64 + cc * 2; return st * 1024 + (ob ^ (((ob >> 9) & 1) << 5)); }
__host__ __device__ __forceinline__ void stage_rc(int b, int& R, int& C) { const int st = b / 1024, sb = b % 1024, swz = sb ^ (((sb >> 9) & 1) << 5); R = (st >> 1) * 16 + swz / 64; C = (st & 1) * 32 + (swz % 64) / 2; }
__host__ __device__ __forceinline__ int perm32(int rho) { const int n = rho >> 4, i = rho & 15; return 8 * (i >> 2) + 4 * n + (i & 3); }

struct Unit { int pm, pn; };
struct Gemm { const bf16_t* A; const bf16_t* Bt; int lda, M, N, K, kslice; };

struct StaticOrder {
    int nM, nN, nwg, G, c;
    __device__ void init(int M, int N, int G_, int c_) { nM = M / BM; nN = N / BM; nwg = nM * nN; G = G_; c = c_; }
    __device__ bool next(int i, Unit& u) const {
        const long L = (long)i * G + c; if (L >= nwg) return false;
        int wgid = (int)L; { const int q = nwg / NXCD, r = nwg % NXCD, xcd = wgid % NXCD, off = wgid / NXCD; wgid = (xcd < r ? xcd * (q + 1) : r * (q + 1) + (xcd - r) * q) + off; }
        const int nig = WGM * nN, gid = wgid / nig, fm = gid * WGM, gsz = (nM - fm) < WGM ? (nM - fm) : WGM;
        u.pm = fm + ((wgid % nig) % gsz); u.pn = (wgid % nig) / gsz; return true;
    }
};

template <class Epi, bool ALIGN_EPI>
__device__ __forceinline__ void gemm_phase(LAS unsigned char* lds, const Gemm g, const StaticOrder S, const Epi E) {
    int tid = threadIdx.x; asm volatile("" : "+v"(tid));
    const int wid = __builtin_amdgcn_readfirstlane(tid >> 6), lane = tid & 63, wr = wid >> 2, wc = wid & 3, fr = lane & 15, fq = lane >> 4;
    const int K = g.K, nt = (g.kslice ? g.kslice : K) / BK, lda = g.lda;
#define PG8_KOFS(u_) (g.kslice ? (size_t)((u_).pn & 3) * (size_t)g.kslice * 2 : (size_t)0)
    unsigned voffA[2], voffB[2];
#pragma unroll
    for (int i = 0; i < 2; ++i) { int R, C; stage_rc(tid * 16 + i * 8192, R, C); const int Rb = Epi::PERM ? ((R & ~31) + perm32(R & 31)) : R;
        voffA[i] = (unsigned)(R * lda + C) * 2u; voffB[i] = (unsigned)(Rb * K + C) * 2u; }
    const size_t kstep = (size_t)(BK * 2);
    const size_t hstepA = (size_t)HALF * lda * 2, hstepB = (size_t)HALF * K * 2;
    const size_t tstepA = 2 * hstepA, tstepB = 2 * hstepB;
    const unsigned ldsw = (unsigned)wid * 1024u;
    const int aoff = lds_byte(wr * 64 + fr, fq * 8), boff = lds_byte(wc * 32 + fr, fq * 8);
#define PG8_SA(b, h) (((b) * 2 + (h)) * HTB)
#define PG8_SB(b, h) ((4 + (b) * 2 + (h)) * HTB)
#define PG8_STAGE(bufoff, gbase, voff) do { _Pragma("unroll") for (int _i = 0; _i < 2; ++_i) \
        __builtin_amdgcn_global_load_lds((const unsigned*)((const char*)(gbase) + (voff)[_i]), (LAS unsigned*)(lds + (bufoff) + ldsw + _i * 8192), 16, 0, 0); } while (0)
#define PG8_LDA(dst, b, h) do { _Pragma("unroll") for (int m = 0; m < 4; ++m) _Pragma("unroll") for (int k = 0; k < 2; ++k) dst[m][k] = *(const LAS bf16x8*)(lds + PG8_SA(b, h) + aoff + m * 2048 + k * 1024); } while (0)
#define PG8_LDB(dst, b, h) do { _Pragma("unroll") for (int n = 0; n < 2; ++n) _Pragma("unroll") for (int k = 0; k < 2; ++k) dst[n][k] = *(const LAS bf16x8*)(lds + PG8_SB(b, h) + boff + n * 2048 + k * 1024); } while (0)
#define PG8_MMA(ai, bj, At, Bt) do { __builtin_amdgcn_s_setprio(1); _Pragma("unroll") for (int m = 0; m < 4; ++m) _Pragma("unroll") for (int n = 0; n < 2; ++n) _Pragma("unroll") for (int k = 0; k < 2; ++k) \
        acc[ai][bj][m][n] = __builtin_amdgcn_mfma_f32_16x16x32_bf16(Bt[n][k], At[m][k], acc[ai][bj][m][n], 0, 0, 0); __builtin_amdgcn_s_setprio(0); } while (0)
#define PG8_WAIT_V(n) asm volatile("s_waitcnt vmcnt(" #n ")" ::: "memory")
#define PG8_WAIT_L(n) asm volatile("s_waitcnt lgkmcnt(" #n ")" ::: "memory")
#define PG8_BAR __builtin_amdgcn_s_barrier()
#define PG8_SCHED __builtin_amdgcn_sched_barrier(0)
    Unit cur, nxt; int ui = 0;
    if (!S.next(0, cur)) return;
    float rs[2][4], rsp[2][4];
#define PG8_RS_ISSUE(u_) do { if constexpr (Epi::ROWSCALE) { _Pragma("unroll") for (int ai_ = 0; ai_ < 2; ++ai_) _Pragma("unroll") for (int m_ = 0; m_ < 4; ++m_) { \
        const f32x4 p_ = *(const f32x4*)(E.part + (size_t)((u_).pm * BM + ai_ * HALF + wr * 64 + m_ * 16 + fr) * 16 + 4 * fq); rsp[ai_][m_] = (p_.x + p_.y) + (p_.z + p_.w); } } } while (0)
#define PG8_RS_FINISH() do { if constexpr (Epi::ROWSCALE) { _Pragma("unroll") for (int ai_ = 0; ai_ < 2; ++ai_) _Pragma("unroll") for (int m_ = 0; m_ < 4; ++m_) rs[ai_][m_] = rsqrtf(fq_sum(rsp[ai_][m_]) * (1.f / DM) + EPS); } \
        else { _Pragma("unroll") for (int ai_ = 0; ai_ < 2; ++ai_) _Pragma("unroll") for (int m_ = 0; m_ < 4; ++m_) rs[ai_][m_] = 1.f; } } while (0)
    PG8_RS_ISSUE(cur);
    f32x4 acc[2][2][4][2];
#pragma unroll
    for (int a = 0; a < 2; ++a)
#pragma unroll
        for (int b = 0; b < 2; ++b)
#pragma unroll
            for (int m = 0; m < 4; ++m)
#pragma unroll
                for (int n = 0; n < 2; ++n) acc[a][b][m][n] = (f32x4){0.f, 0.f, 0.f, 0.f};
    bf16x8 At[4][2], B0[2][2], B1[2][2];
    const char* cA = (const char*)g.A + (size_t)cur.pm * tstepA + PG8_KOFS(cur); const char* cB = (const char*)g.Bt + (size_t)cur.pn * tstepB + PG8_KOFS(cur);
    PG8_STAGE(PG8_SB(0, 0), cB, voffB); PG8_STAGE(PG8_SB(0, 1), cB + hstepB, voffB); PG8_STAGE(PG8_SA(0, 0), cA, voffA); PG8_STAGE(PG8_SA(0, 1), cA + hstepA, voffA);
    if (wr == 1) PG8_BAR;
    PG8_WAIT_V(2); PG8_BAR;
    PG8_STAGE(PG8_SB(1, 0), cB + kstep, voffB); PG8_STAGE(PG8_SA(1, 0), cA + kstep, voffA); PG8_STAGE(PG8_SB(1, 1), cB + hstepB + kstep, voffB);
    PG8_WAIT_V(6); PG8_BAR;
    PG8_RS_FINISH();
    for (;;) {
        const bool has_next = S.next(ui + 1, nxt);
        const char* nA = has_next ? (const char*)g.A + (size_t)nxt.pm * tstepA + PG8_KOFS(nxt) : cA; const char* nB = has_next ? (const char*)g.Bt + (size_t)nxt.pn * tstepB + PG8_KOFS(nxt) : cB;
#pragma unroll 1
        for (int t = 0; t < nt; t += 2) {
            const bool last = (t == nt - 2);
            const char* a1 = cA + (size_t)(t + 1) * kstep;
            const char* a2 = last ? nA : cA + (size_t)(t + 2) * kstep; const char* b2 = last ? nB : cB + (size_t)(t + 2) * kstep;
            const char* a3 = a2 + kstep; const char* b3 = b2 + kstep;
            PG8_LDB(B0, 0, 0); PG8_LDB(B1, 0, 1); PG8_SCHED; PG8_LDA(At, 0, 0); PG8_STAGE(PG8_SA(1, 1), a1 + hstepA, voffA);
            PG8_WAIT_V(8); PG8_WAIT_L(0); PG8_BAR; PG8_MMA(0, 0, At, B0); PG8_MMA(0, 1, At, B1); PG8_BAR; PG8_SCHED;
            PG8_LDA(At, 0, 1); PG8_STAGE(PG8_SB(0, 0), b2, voffB); PG8_STAGE(PG8_SB(0, 1), b2 + hstepB, voffB); PG8_STAGE(PG8_SA(0, 0), a2, voffA);
            PG8_WAIT_V(8); PG8_WAIT_L(0); PG8_BAR; PG8_MMA(1, 0, At, B0); PG8_MMA(1, 1, At, B1); PG8_BAR; PG8_SCHED;
            PG8_LDB(B0, 1, 0); PG8_LDB(B1, 1, 1); PG8_SCHED; PG8_LDA(At, 1, 0); PG8_STAGE(PG8_SA(0, 1), a2 + hstepA, voffA);
            PG8_WAIT_V(8); PG8_WAIT_L(0); PG8_BAR; PG8_MMA(0, 0, At, B0); PG8_MMA(0, 1, At, B1); PG8_BAR; PG8_SCHED;
            PG8_LDA(At, 1, 1); PG8_STAGE(PG8_SB(1, 0), b3, voffB); PG8_STAGE(PG8_SB(1, 1), b3 + hstepB, voffB); PG8_STAGE(PG8_SA(1, 0), a3, voffA);
            PG8_WAIT_V(8); PG8_WAIT_L(0); PG8_BAR; PG8_MMA(1, 0, At, B0); PG8_MMA(1, 1, At, B1); PG8_BAR; PG8_SCHED;
        }
        if constexpr (ALIGN_EPI) { if (wr == 0) PG8_BAR; }
        if (has_next) PG8_RS_ISSUE(nxt);
        E(acc, cur, wr, wc, fr, fq, rs);
        if (!has_next) break;
        PG8_RS_FINISH();
#pragma unroll
        for (int a = 0; a < 2; ++a)
#pragma unroll
            for (int b = 0; b < 2; ++b)
#pragma unroll
                for (int m = 0; m < 4; ++m)
#pragma unroll
                    for (int n = 0; n < 2; ++n) acc[a][b][m][n] = (f32x4){0.f, 0.f, 0.f, 0.f};
        cur = nxt; cA = nA; cB = nB; ++ui;
        if constexpr (ALIGN_EPI) { if (wr == 1) PG8_BAR; }
    }
    PG8_WAIT_V(0);
    if constexpr (!ALIGN_EPI) { if (wr == 0) PG8_BAR; }
    PG8_BAR;
#undef PG8_KOFS
#undef PG8_RS_ISSUE
#undef PG8_RS_FINISH
#undef PG8_SA
#undef PG8_SB
#undef PG8_STAGE
#undef PG8_LDA
#undef PG8_LDB
#undef PG8_MMA
#undef PG8_WAIT_V
#undef PG8_WAIT_L
#undef PG8_BAR
#undef PG8_SCHED
}

template <bool SCALE> struct EpiStore {
    static constexpr bool PERM = true, ROWSCALE = SCALE;
    bf16_t* O; int ldc; const float* part;
    __device__ __forceinline__ void operator()(const f32x4 (&acc)[2][2][4][2], const Unit& u, int wr, int wc, int fr, int fq, const float (&rs)[2][4]) const {
        asm volatile("" : "+v"(fr), "+v"(fq));
        const int row0 = u.pm * BM + wr * 64 + fr, col0 = u.pn * BM + wc * 32 + 8 * fq;
#pragma unroll
        for (int ai = 0; ai < 2; ++ai)
#pragma unroll
            for (int m = 0; m < 4; ++m) { bf16_t* rowp = O + (size_t)(row0 + ai * HALF + m * 16) * ldc + col0;
                const float rsv = SCALE ? rs[ai][m] : 1.0f;
#pragma unroll
                for (int bj = 0; bj < 2; ++bj) { const f32x4 v0 = acc[ai][bj][m][0] * rsv, v1 = acc[ai][bj][m][1] * rsv;
                    u32x4 w; w.x = cvt_pk_bf16(v0[0], v0[1]); w.y = cvt_pk_bf16(v0[2], v0[3]); w.z = cvt_pk_bf16(v1[0], v1[1]); w.w = cvt_pk_bf16(v1[2], v1[3]);
                    *(u32x4*)(rowp + bj * HALF) = w; } }
    }
};
struct EpiSwiglu {
    static constexpr bool PERM = true, ROWSCALE = true;
    bf16_t* O; const float* part;
    __device__ __forceinline__ void operator()(const f32x4 (&acc)[2][2][4][2], const Unit& u, int wr, int wc, int fr, int fq, const float (&rs)[2][4]) const {
        asm volatile("" : "+v"(fr), "+v"(fq));
        const int row0 = u.pm * BM + wr * 64 + fr, col0 = u.pn * HALF + wc * 32 + 8 * fq;
#pragma unroll
        for (int ai = 0; ai < 2; ++ai)
#pragma unroll
            for (int m = 0; m < 4; ++m) { bf16_t* rowp = O + (size_t)(row0 + ai * HALF + m * 16) * FF + col0;
                float r[8], e[8]; const float rsv = rs[ai][m]; const float c1 = -rsv * LOG2E, c2 = rsv * rsv;
#pragma unroll
                for (int j = 0; j < 8; ++j) { const float gv = acc[ai][0][m][j >> 2][j & 3], uv = acc[ai][1][m][j >> 2][j & 3]; e[j] = gv * c1; r[j] = gv * uv; }
                __builtin_amdgcn_sched_barrier(0);
#pragma unroll
                for (int j = 0; j < 8; ++j) e[j] = __builtin_amdgcn_exp2f(e[j]);
                __builtin_amdgcn_sched_barrier(0);
#pragma unroll
                for (int j = 0; j < 8; ++j) e[j] = 1.0f + e[j];
                __builtin_amdgcn_sched_barrier(0);
#pragma unroll
                for (int j = 0; j < 8; ++j) e[j] = __builtin_amdgcn_rcpf(e[j]);
                __builtin_amdgcn_sched_barrier(0);
#pragma unroll
                for (int j = 0; j < 8; ++j) r[j] = r[j] * (c2 * e[j]);
                u32x4 w; w.x = cvt_pk_bf16(r[0], r[1]); w.y = cvt_pk_bf16(r[2], r[3]); w.z = cvt_pk_bf16(r[4], r[5]); w.w = cvt_pk_bf16(r[6], r[7]);
                *(u32x4*)rowp = w; }
    }
};
struct EpiRes {
    static constexpr bool PERM = true, ROWSCALE = false;
    bf16_t* X; float* part; float alpha;
    __device__ __forceinline__ void operator()(const f32x4 (&acc)[2][2][4][2], const Unit& u, int wr, int wc, int fr, int fq, const float (&rs)[2][4]) const {
        asm volatile("" : "+v"(fr), "+v"(fq));
        const int row0 = u.pm * BM + wr * 64 + fr, col0 = u.pn * BM + wc * 32 + 8 * fq;
#pragma unroll
        for (int ai = 0; ai < 2; ++ai) {
#pragma unroll
            for (int m = 0; m < 4; ++m) { bf16_t* rowp = X + (size_t)(row0 + ai * HALF + m * 16) * DM + col0; float ss = 0.f;
#pragma unroll
                for (int bj = 0; bj < 2; ++bj) { const u32x4 bw = *(const u32x4*)(rowp + bj * HALF); const f32x4 a0 = acc[ai][bj][m][0], a1 = acc[ai][bj][m][1];
                    u32x4 w; w.x = cvt_pk_bf16(bf_lo(bw.x) + alpha * a0[0], bf_hi(bw.x) + alpha * a0[1]); w.y = cvt_pk_bf16(bf_lo(bw.y) + alpha * a0[2], bf_hi(bw.y) + alpha * a0[3]);
                    w.z = cvt_pk_bf16(bf_lo(bw.z) + alpha * a1[0], bf_hi(bw.z) + alpha * a1[1]); w.w = cvt_pk_bf16(bf_lo(bw.w) + alpha * a1[2], bf_hi(bw.w) + alpha * a1[3]);
                    *(u32x4*)(rowp + bj * HALF) = w;
                    ss += (bf_lo(w.x) * bf_lo(w.x) + bf_hi(w.x) * bf_hi(w.x)) + (bf_lo(w.y) * bf_lo(w.y) + bf_hi(w.y) * bf_hi(w.y));
                    ss += (bf_lo(w.z) * bf_lo(w.z) + bf_hi(w.z) * bf_hi(w.z)) + (bf_lo(w.w) * bf_lo(w.w) + bf_hi(w.w) * bf_hi(w.w)); }
                ss = fq_sum(ss);
                if (fq == 0) part[(size_t)(row0 + ai * HALF + m * 16) * 16 + u.pn * 4 + wc] = ss; } }
    }
};
struct EpiQRope {
    static constexpr bool PERM = true, ROWSCALE = false;
    bf16_t* O; const float* tab;
    __device__ __forceinline__ void operator()(const f32x4 (&acc)[2][2][4][2], const Unit& u, int wr, int wc, int fr, int fq, const float (&rs)[2][4]) const {
        asm volatile("" : "+v"(fr), "+v"(fq));
        const int row0 = u.pm * BM + wr * 64 + fr;
        const int pmask = (u.pm < TP / BM) ? 8191 : 4095;
#pragma unroll
        for (int bj = 0; bj < 2; ++bj) {
            const int cb = u.pn * BM + bj * HALF + wc * 32 + 8 * fq; const int d = cb % 96; const bool rope = d >= 64; const int i0 = rope ? ((d - 64) >> 1) : 0;
#pragma unroll
            for (int ai = 0; ai < 2; ++ai)
#pragma unroll
                for (int m = 0; m < 4; ++m) { const int row = row0 + ai * HALF + m * 16; f32x4 v0 = acc[ai][bj][m][0], v1 = acc[ai][bj][m][1];
                    if (rope) { const float* cs = tab + ((size_t)(row & pmask) * 16 + i0) * 2; const f32x4 c01 = *(const f32x4*)cs, c23 = *(const f32x4*)(cs + 4);
                        const f32x4 a = v0, b = v1;
                        v0[0] = a[0] * c01[0] - a[1] * c01[1]; v0[1] = a[0] * c01[1] + a[1] * c01[0];
                        v0[2] = a[2] * c01[2] - a[3] * c01[3]; v0[3] = a[2] * c01[3] + a[3] * c01[2];
                        v1[0] = b[0] * c23[0] - b[1] * c23[1]; v1[1] = b[0] * c23[1] + b[1] * c23[0];
                        v1[2] = b[2] * c23[2] - b[3] * c23[3]; v1[3] = b[2] * c23[3] + b[3] * c23[2]; }
                    u32x4 w; w.x = cvt_pk_bf16(v0[0], v0[1]); w.y = cvt_pk_bf16(v0[2], v0[3]); w.z = cvt_pk_bf16(v1[0], v1[1]); w.w = cvt_pk_bf16(v1[2], v1[3]);
                    *(u32x4*)(O + (size_t)row * 768 + cb) = w;
                    asm volatile("" ::: "memory"); }
        }
    }
};
struct EpiLru {
    static constexpr bool PERM = true, ROWSCALE = false;
    bf16_t* LA; bf16_t* U; const bf16_t* XC; const float* b_a; const float* b_x; const float* lam;
    __device__ __forceinline__ void operator()(const f32x4 (&acc)[2][2][4][2], const Unit& u, int wr, int wc, int fr, int fq, const float (&rs)[2][4]) const {
        asm volatile("" : "+v"(fr), "+v"(fq));
        const int row0 = u.pm * BM + wr * 64 + fr; const int dir = u.pn >> 2, cbase = (u.pn & 3) * HALF + wc * 32 + 8 * fq;
        float ba[8], bx[8], sp[8];
#pragma unroll
        for (int j = 0; j < 8; ++j) { ba[j] = b_a[dir * 512 + cbase + j]; bx[j] = b_x[dir * 512 + cbase + j];
            const float e = __expf(-lam[dir * 512 + cbase + j]);
            sp[j] = 8.0f * LOG2E * (e < 0.02f ? e * (1.0f - e * (0.5f - e * (0.33333333f - 0.25f * e))) : __logf(1.0f + e)); }
#pragma unroll
        for (int ai = 0; ai < 2; ++ai)
#pragma unroll
            for (int m = 0; m < 4; ++m) { const int row = row0 + ai * HALF + m * 16;
                const u32x4 xw = *(const u32x4*)(XC + (size_t)row * 512 + cbase);
                float xc[8] = {bf_lo(xw.x), bf_hi(xw.x), bf_lo(xw.y), bf_hi(xw.y), bf_lo(xw.z), bf_hi(xw.z), bf_lo(xw.w), bf_hi(xw.w)};
                float la[8], uu[8];
#pragma unroll
                for (int j = 0; j < 8; ++j) { const float r = sigmoidf_(acc[ai][0][m][j >> 2][j & 3] + ba[j]), ig = sigmoidf_(acc[ai][1][m][j >> 2][j & 3] + bx[j]);
                    la[j] = -r * sp[j]; const float a2 = __builtin_amdgcn_exp2f(2.0f * la[j]); uu[j] = __builtin_sqrtf(fmaxf(1.0f - a2, 0.0f)) * ig * xc[j]; }
                u32x4 w; w.x = cvt_pk_bf16(la[0], la[1]); w.y = cvt_pk_bf16(la[2], la[3]); w.z = cvt_pk_bf16(la[4], la[5]); w.w = cvt_pk_bf16(la[6], la[7]);
                *(u32x4*)(LA + (size_t)row * 1024 + dir * 512 + cbase) = w;
                w.x = cvt_pk_bf16(uu[0], uu[1]); w.y = cvt_pk_bf16(uu[2], uu[3]); w.z = cvt_pk_bf16(uu[4], uu[5]); w.w = cvt_pk_bf16(uu[6], uu[7]);
                *(u32x4*)(U + (size_t)row * 1024 + dir * 512 + cbase) = w; }
    }
};
}

template <class Epi, bool ALIGN>
__device__ __forceinline__ void run_gemm(LAS unsigned char* lds, const bf16_t* A, int lda, const bf16_t* Bt, int N, int K, const Epi E, int cidx, int kslice = 0) {
    pg8::Gemm g{A, Bt, lda, T, N, K, kslice}; pg8::StaticOrder S; S.init(T, N, (int)gridDim.x, cidx);
    pg8::gemm_phase<Epi, ALIGN>(lds, g, S, E);
}

namespace att {
typedef LAS const char* lds_cptr;
typedef short v4i16_t __attribute__((ext_vector_type(4)));
constexpr int KSLOT = 12288, VSLOT = 8192;
constexpr int LDS_K = 0, LDS_V = 2 * KSLOT, LDS_WS = LDS_V + 3 * VSLOT, LDS_OST = LDS_WS + 8 * 256, LDS_END = LDS_OST + 8 * 4096;
__device__ __forceinline__ int crow(int r, int hi) { return (r & 3) + 8 * (r >> 2) + 4 * hi; }
__device__ __forceinline__ void glds16(const void* gsrc, unsigned lds_dst) { unsigned keep;
    asm volatile("s_mov_b32 %0, m0\n\ts_mov_b32 m0, %2\n\ts_nop 0\n\tglobal_load_lds_dwordx4 %1, off\n\ts_mov_b32 m0, %0" : "=&s"(keep) : "v"(gsrc), "s"(lds_dst) : "memory"); }
__device__ __forceinline__ s16x4 vtr(lds_cptr p) { return __builtin_bit_cast(s16x4, __builtin_amdgcn_ds_read_tr16_b64_v4i16((LAS v4i16_t*)p)); }
__device__ __forceinline__ float halfmax(float m) { auto rr = __builtin_amdgcn_permlane32_swap(__float_as_uint(m), __float_as_uint(m), false, false); return fmaxf(__uint_as_float(rr[0]), __uint_as_float(rr[1])); }
__device__ __forceinline__ float halfsum(float m) { auto rr = __builtin_amdgcn_permlane32_swap(__float_as_uint(m), __float_as_uint(m), false, false); return __uint_as_float(rr[0]) + __uint_as_float(rr[1]); }

struct Unit { const bf16_t* Q; int ldq; const bf16_t* K; int ldk; const bf16_t* KPE; const bf16_t* V; int ldv; bf16_t* O; int ldo; int t_lo, t_hi, qpos0; float slope2, sink2; };

template <int MODE> __device__ __forceinline__ void attn_unit(const Unit& a, char* shm) {
    constexpr int ND = MODE == 0 ? 6 : 4;
    constexpr float THR = 8.0f;
    int tid = threadIdx.x; asm volatile("" : "+v"(tid));
    const int lane = tid & 63, r32 = lane & 31, hi = lane >> 5; const int wid = __builtin_amdgcn_readfirstlane(tid >> 6);
    const unsigned lds0 = (unsigned)(uintptr_t)shm; const lds_cptr shm3 = (lds_cptr)shm;
    LAS float* wsf = (LAS float*)(shm3 + LDS_WS) + wid * 64;
    const bf16_t* ksrc = a.K + (long)lane * a.ldk + wid * 8;
    const bf16_t* kpsrc = a.KPE + (long)lane * 32 + (wid & 3) * 8;
    const bf16_t* vsrc = a.V + (long)(16 * (wid & 3) + (lane >> 2)) * a.ldv + (wid >> 2) * 32 + (lane & 3) * 8;
    const unsigned kdst = lds0 + LDS_K + wid * 1024, kpdst = lds0 + LDS_K + (8 + (wid & 3)) * 1024, vdst = lds0 + LDS_V + wid * 1024;
#define ATT_DMA(t, sk, sv) do { glds16(ksrc + (long)(t) * 64 * a.ldk, (unsigned)__builtin_amdgcn_readfirstlane(kdst + (sk) * KSLOT)); \
        if (MODE == 0 && wid < 4) glds16(kpsrc + (long)(t) * 64 * 32, (unsigned)__builtin_amdgcn_readfirstlane(kpdst + (sk) * KSLOT)); \
        glds16(vsrc + (long)(t) * 64 * a.ldv, (unsigned)__builtin_amdgcn_readfirstlane(vdst + (sv) * VSLOT)); } while (0)
#define ATT_WAIT_BAR() asm volatile("s_waitcnt vmcnt(0) lgkmcnt(0)\n\ts_barrier" ::: "memory")
#define ATT_PV(PW, vslot) do { const lds_cptr vp_ = vp0 + (vslot) * VSLOT; \
        _Pragma("unroll") for (int d0 = 0; d0 < 2; ++d0) _Pragma("unroll") for (int ks = 0; ks < 4; ++ks) { \
            const s16x4 lo_ = vtr(vp_ + d0 * 4096 + ks * 1024), hh_ = vtr(vp_ + d0 * 4096 + ks * 1024 + 512); \
            const bf16x8 vf_ = (bf16x8){lo_[0], lo_[1], lo_[2], lo_[3], hh_[0], hh_[1], hh_[2], hh_[3]}; \
            o[d0] = __builtin_amdgcn_mfma_f32_32x32x16_bf16(__builtin_bit_cast(bf16x8, (PW)[ks]), vf_, o[d0], 0, 0, 0); } } while (0)
    const int g = wid >> 2;
    ATT_DMA(a.t_lo, 0, 0);
    bf16x8 qr[ND];
    { const bf16_t* Qw = a.Q + (long)(wid * 32 + r32) * a.ldq + hi * 8;
#pragma unroll
      for (int d0 = 0; d0 < ND; ++d0) qr[d0] = *(const bf16x8*)(Qw + d0 * 16); }
    float mhat = (MODE == 1) ? a.sink2 : 0.f;
    float l_reg = (MODE == 1 && hi == 0) ? 1.f : 0.f;
    f32x16 o[2]; o[0] = f32x16{}; o[1] = f32x16{};
    f32x16 negm;
#pragma unroll
    for (int r = 0; r < 16; ++r) negm[r] = -mhat;
    const int tq0 = a.qpos0 + wid * 32, tq = tq0 + r32;
    const lds_cptr vp0 = shm3 + LDS_V + ((lane >> 4) & 1) * 32 + (lane & 3) * 8 + (4 * hi + ((lane & 15) >> 2)) * 64;
    u32x4 pw[4]; pw[0] = (u32x4){0u, 0u, 0u, 0u}; pw[1] = pw[0]; pw[2] = pw[0]; pw[3] = pw[0];
    bool pend = false; int sv = 0, svp = 0;
    for (int t = a.t_lo; t < a.t_hi; ++t) {
        const int s = (t - a.t_lo) & 1;
        ATT_WAIT_BAR();
        if (t + 1 < a.t_hi) ATT_DMA(t + 1, s ^ 1, (sv == 2 ? 0 : sv + 1));
        if (pend) { ATT_PV(pw, svp); pend = false; }
        bool active = true;
        if (MODE == 1) active = (64 * t + 63 >= tq0 - 128) && (64 * t <= tq0 + 31 + 128);
        if (active) {
            const lds_cptr kp = shm3 + LDS_K + s * KSLOT + hi * 1024 + r32 * 16;
            f32x16 p0 = negm, p1 = negm;
#pragma unroll
            for (int d0 = 0; d0 < ND; ++d0) {
                const bf16x8 b0 = *(const LAS bf16x8*)(kp + d0 * 2048), b1 = *(const LAS bf16x8*)(kp + d0 * 2048 + 512);
                p0 = __builtin_amdgcn_mfma_f32_32x32x16_bf16(b0, qr[d0], p0, 0, 0, 0);
                p1 = __builtin_amdgcn_mfma_f32_32x32x16_bf16(b1, qr[d0], p1, 0, 0, 0);
            }
            if (MODE == 1) {
#pragma unroll
                for (int r = 0; r < 16; ++r) { const int ks = 64 * t + crow(r, hi); const int r0 = abs(tq - ks), r1 = abs(tq - ks - 32);
                    p0[r] = (r0 <= 128) ? p0[r] - a.slope2 * (float)r0 : -INFINITY; p1[r] = (r1 <= 128) ? p1[r] - a.slope2 * (float)r1 : -INFINITY; }
            }
#define MX3(a_, b_, c_) __builtin_fmaxf(__builtin_fmaxf((a_), (b_)), (c_))
            float ra = MX3(p0[0], p0[1], p1[0]), rb = MX3(p0[2], p0[3], p1[1]); ra = MX3(ra, p1[2], p1[3]);
#pragma unroll
            for (int r = 4; r < 16; r += 4) { ra = MX3(ra, p0[r], p0[r + 1]); rb = MX3(rb, p0[r + 2], p0[r + 3]); ra = MX3(ra, p1[r], p1[r + 1]); rb = MX3(rb, p1[r + 2], p1[r + 3]); }
#undef MX3
            float rm = halfmax(__builtin_fmaxf(ra, rb));
            const bool first = (MODE == 0) && (t == a.t_lo);
            if (first || __any(rm > THR)) {
                const float dl = first ? rm : fmaxf(rm, 0.f);
                mhat += dl;
#pragma unroll
                for (int r = 0; r < 16; ++r) { p0[r] -= dl; p1[r] -= dl; negm[r] = -mhat; }
                if (!first) {
                    const float f = __builtin_amdgcn_exp2f(-dl); l_reg *= f;
                    if (hi == 0) wsf[r32] = f;
#pragma unroll
                    for (int r = 0; r < 16; ++r) { const float fr_ = wsf[crow(r, hi)]; o[0][r] *= fr_; o[1][r] *= fr_; }
                }
            }
#pragma unroll
            for (int r = 0; r < 16; ++r) { p0[r] = __builtin_amdgcn_exp2f(p0[r]); p1[r] = __builtin_amdgcn_exp2f(p1[r]); }
            f32x2 s2a = (f32x2){p0[0], p0[1]}, s2b = (f32x2){p1[0], p1[1]};
#pragma unroll
            for (int k2 = 1; k2 < 8; ++k2) { s2a += (f32x2){p0[2 * k2], p0[2 * k2 + 1]}; s2b += (f32x2){p1[2 * k2], p1[2 * k2 + 1]}; }
            s2a += s2b;
            l_reg += s2a.x + s2a.y;
#pragma unroll
            for (int kk = 0; kk < 4; ++kk) { pw[0][kk] = cvt_pk_bf16(p0[2 * kk], p0[2 * kk + 1]); pw[1][kk] = cvt_pk_bf16(p0[8 + 2 * kk], p0[8 + 2 * kk + 1]);
                pw[2][kk] = cvt_pk_bf16(p1[2 * kk], p1[2 * kk + 1]); pw[3][kk] = cvt_pk_bf16(p1[8 + 2 * kk], p1[8 + 2 * kk + 1]); }
            if (g == 0) ATT_PV(pw, sv); else pend = true;
        }
        svp = sv; sv = (sv == 2) ? 0 : sv + 1;
    }
    if (pend) ATT_PV(pw, svp);
    l_reg = halfsum(l_reg);
    if (hi == 0) wsf[32 + r32] = l_reg;
    float rli[16];
#pragma unroll
    for (int r = 0; r < 16; ++r) rli[r] = __builtin_amdgcn_rcpf(wsf[32 + crow(r, hi)]);
    { LAS bf16_t* stg = (LAS bf16_t*)(shm3 + LDS_OST) + wid * 2048;
#pragma unroll
      for (int r = 0; r < 16; ++r) { const int orow = crow(r, hi);
#pragma unroll
          for (int d0 = 0; d0 < 2; ++d0) stg[orow * 64 + d0 * 32 + r32] = (bf16_t)(cvt_pk_bf16(o[d0][r] * rli[r], 0.f) & 0xffffu); }
      bf16_t* Ow = a.O + (long)(wid * 32) * a.ldo;
#pragma unroll
      for (int i = 0; i < 4; ++i) { const int row = i * 8 + (lane >> 3), ch = lane & 7; const u32x4 v = *(const LAS u32x4*)(stg + row * 64 + ch * 8); *(u32x4*)(Ow + (long)row * a.ldo + ch * 8) = v; } }
    asm volatile("s_waitcnt vmcnt(0) lgkmcnt(0)\n\ts_barrier" ::: "memory");
#undef ATT_DMA
#undef ATT_WAIT_BAR
#undef ATT_PV
}
}


#define XB_TMO      128
#define XB_XCNT(j)  (256  + 64 * (j))
#define XB_XSUB(j)  (1280 + 64 * (j))
#define XB_XGEN(j)  (2304 + 64 * (j))
#define XB_TOP      3328
#define XB_TOPGEN   3392
#define XCD_BAR_WORDS 3456
#define XL_CNT(j)   (3584 + 64 * (j))
#define XB_SPIN_CAP (1u << 22)
__device__ __forceinline__ unsigned xb_ld(unsigned* p)              { return __hip_atomic_load(p, __ATOMIC_RELAXED, __HIP_MEMORY_SCOPE_AGENT); }
__device__ __forceinline__ unsigned xb_add(unsigned* p, unsigned v) { return __hip_atomic_fetch_add(p, v, __ATOMIC_RELAXED, __HIP_MEMORY_SCOPE_AGENT); }
__device__ __forceinline__ unsigned xb_xcc_id() { return (unsigned)__builtin_amdgcn_s_getreg((3 << 11) | 20) & 0xFu; }
#define XB_SPIN(cond, bar) do { unsigned _sp = 0; while (cond) { __builtin_amdgcn_s_sleep(1); \
    if ((++_sp & 255u) == 0u) { if (xb_ld(&(bar)[XB_TMO])) break; if (_sp > XB_SPIN_CAP) { atomicAdd(&(bar)[XB_TMO], 1u); break; } } } } while (0)
struct XcdBarrier { unsigned* bar; unsigned x; volatile LAS unsigned* st; };
__device__ __forceinline__ XcdBarrier xcd_barrier_post(unsigned* bar, volatile LAS unsigned* st) {
    XcdBarrier b; b.bar = bar; b.x = xb_xcc_id(); b.st = st;
    if (threadIdx.x == 0) (void)xb_add(&bar[XB_XCNT(b.x)], 1u);
    return b;
}
__device__ __forceinline__ void xcd_barrier_complete(unsigned* bar, unsigned x, unsigned& nloc, unsigned& nx) {
    const unsigned G = gridDim.x * gridDim.y * gridDim.z;
    unsigned sum, cnt, mine, sp = 0u;
    for (;;) {
        sum = 0u; cnt = 0u; mine = 0u;
#pragma unroll
        for (unsigned j = 0; j < 16; ++j) { const unsigned c = xb_ld(&bar[XB_XCNT(j)]); sum += c; cnt += (c > 0u) ? 1u : 0u; mine = (j == x) ? c : mine; }
        if (sum == G) break;
        __builtin_amdgcn_s_sleep(1);
        if ((++sp & 255u) == 0u) { if (xb_ld(&bar[XB_TMO])) break; if (sp > XB_SPIN_CAP) { atomicAdd(&bar[XB_TMO], 1u); break; } }
    }
    nloc = mine > 0u ? mine : 1u; nx = cnt > 0u ? cnt : 1u;
}
__device__ __forceinline__ void xcd_barrier(const XcdBarrier& b) {
    asm volatile("s_waitcnt vmcnt(0)" ::: "memory");
    __syncthreads();
    if (threadIdx.x == 0) {
        unsigned* bar = b.bar;
        __builtin_amdgcn_s_waitcnt(0);
        unsigned nloc = b.st[0], nx = b.st[1];
        if (nloc == 0u) { xcd_barrier_complete(bar, b.x, nloc, nx); b.st[0] = nloc; b.st[1] = nx; }
        const unsigned old = xb_add(&bar[XB_XSUB(b.x)], 1u);
        const unsigned gen = old / nloc;
        if (old + 1u == (gen + 1u) * nloc) {
            __builtin_amdgcn_fence(__ATOMIC_RELEASE, "agent");
            asm volatile("s_waitcnt vmcnt(0)" ::: "memory");
            const unsigned og = xb_add(&bar[XB_TOP], 1u);
            const unsigned tg = og / nx;
            if (og + 1u == (tg + 1u) * nx) xb_add(&bar[XB_TOPGEN], 1u);
            else XB_SPIN(xb_ld(&bar[XB_TOPGEN]) == tg, bar);
            __builtin_amdgcn_fence(__ATOMIC_ACQUIRE, "agent");
            xb_add(&bar[XB_XGEN(b.x)], 1u);
            asm volatile("s_waitcnt vmcnt(0)" ::: "memory");
        } else {
            XB_SPIN(xb_ld(&bar[XB_XGEN(b.x)]) == gen, bar);
            __builtin_amdgcn_fence(__ATOMIC_ACQUIRE, "agent");
            asm volatile("s_waitcnt vmcnt(0)" ::: "memory");
        }
    }
    __syncthreads();
}

__device__ __forceinline__ void xcd_local_barrier(const XcdBarrier& b, unsigned nloc) {
    asm volatile("s_waitcnt vmcnt(0)" ::: "memory");
    __syncthreads();
    if (threadIdx.x == 0) {
        unsigned* bar = b.bar;
        __builtin_amdgcn_s_waitcnt(0);
        const unsigned lgen = b.st[5] + 1u; b.st[5] = lgen;
        (void)xb_add(&bar[XL_CNT(b.x)], 1u);
        const unsigned target = lgen * nloc;
        XB_SPIN(xb_ld(&bar[XL_CNT(b.x)]) < target, bar);
        __builtin_amdgcn_fence(__ATOMIC_ACQUIRE, "agent");
        asm volatile("s_waitcnt vmcnt(0)" ::: "memory");
    }
    __syncthreads();
}

struct Params { const float* in[25]; float* out; unsigned char* ws; int ph_lo, ph_hi; };
enum { I_XP = 0, I_XS, I_FFN_NORM, I_FFN_G, I_FFN_U, I_FFN_D, I_MIX_NORM, I_EV_IN, I_EV_CONV, I_Q_NORM, I_W_UQ, I_KV_NORM, I_W_UKV, I_EV_OUT,
       I_OD_IN, I_OD_CONV, I_OD_CONVB, I_LRU_WA, I_LRU_BA, I_LRU_WX, I_LRU_BX, I_LRU_LAM, I_SINK, I_OD_OUT, I_FINAL_NORM };

__device__ __forceinline__ int rope_perm(int j) { return j < 16 ? 2 * j : 2 * (j - 16) + 1; }

struct PrepJob { const float* W; const float* gain; bf16_t* WT; float scale; int N, K, mode, kb, nb; };
__device__ __forceinline__ void prep_load(const PrepJob& j, int lane, f32x4 (&v)[16]) {
    const int k0 = 64 * j.kb, n0 = 64 * j.nb, cq = (lane & 15) * 4, rq = lane >> 4;
    const bool colok = (n0 + cq) < j.N;
#pragma unroll
    for (int i = 0; i < 16; ++i) v[i] = colok ? *(const f32x4*)(j.W + (size_t)(k0 + 4 * i + rq) * j.N + n0 + cq) : (f32x4){0.f, 0.f, 0.f, 0.f};
}
__device__ __forceinline__ void prep_store(const PrepJob& j, int lane, const f32x4 (&v)[16], LAS float* scr) {
    const int k0 = 64 * j.kb, n0 = 64 * j.nb, cq = (lane & 15) * 4, rq = lane >> 4, mode = j.mode;
#pragma unroll
    for (int i = 0; i < 16; ++i) { LAS float* d = scr + (4 * i + rq) * 65 + cq; d[0] = v[i].x; d[1] = v[i].y; d[2] = v[i].z; d[3] = v[i].w; }
    asm volatile("s_waitcnt lgkmcnt(0)" ::: "memory");
    const int c = lane & 7;
    float g[8];
#pragma unroll
    for (int e = 0; e < 8; ++e) g[e] = (j.gain ? j.gain[k0 + 8 * c + e] : 1.0f) * j.scale;
#pragma unroll
    for (int jj = 0; jj < 8; ++jj) { const int n = (lane >> 3) + 8 * jj; const LAS float* sp = scr + (8 * c) * 65 + n;
        u32x4 o; o.x = cvt_pk_bf16(sp[0 * 65] * g[0], sp[1 * 65] * g[1]); o.y = cvt_pk_bf16(sp[2 * 65] * g[2], sp[3 * 65] * g[3]); o.z = cvt_pk_bf16(sp[4 * 65] * g[4], sp[5 * 65] * g[5]); o.w = cvt_pk_bf16(sp[6 * 65] * g[6], sp[7 * 65] * g[7]);
        const int ns = n0 + n; int row;
        if (mode == 0) row = ns;
        else if (mode == 1) row = (ns >> 7) * 256 + (ns & 127);
        else if (mode == 2) row = (ns >> 7) * 256 + 128 + (ns & 127);
        else if (mode == 3) { const int h = ns / 96, d = ns % 96; row = h * 96 + (d < 64 ? d : 64 + rope_perm(d - 64)); }
        else if (mode == 4) row = ns < 2176 ? ns : 2176 + rope_perm(ns - 2176);
        else row = ns < 512 ? ns : (ns < 1024 ? ns + 512 : (ns < 1536 ? ns - 512 : ns));
        if (ns < j.N) *(u32x4*)(j.WT + (size_t)row * j.K + k0 + 8 * c) = o; }
    asm volatile("s_waitcnt lgkmcnt(0)" ::: "memory");
}

__device__ __forceinline__ void norm_row(const float* xrow, bf16_t* orow, float* prow, int lane) {
    const f32x4* xr = (const f32x4*)xrow + lane;
    f32x4 v[4]; float s = 0.f;
#pragma unroll
    for (int j = 0; j < 4; ++j) { v[j] = xr[64 * j]; s += (v[j].x * v[j].x + v[j].y * v[j].y) + (v[j].z * v[j].z + v[j].w * v[j].w); }
    const float tot = wave_sum(s);
    if (lane < 16) prow[lane] = lane == 0 ? tot : 0.f;
    u32x2* o8 = (u32x2*)orow + lane;
#pragma unroll
    for (int j = 0; j < 4; ++j) { u32x2 w; w.x = cvt_pk_bf16(v[j].x, v[j].y); w.y = cvt_pk_bf16(v[j].z, v[j].w); o8[64 * j] = w; }
}
__device__ __forceinline__ void norm_phase(const float* src0, const float* src1, bf16_t* XN, float* part, int gw, int NGW, int lane) {
    for (int m = gw; m < T; m += NGW) norm_row(m < TP ? src0 + (size_t)m * DM : src1 + (size_t)(m - TP) * DM, XN + (size_t)m * DM, part + (size_t)m * 16, lane);
}
__device__ __forceinline__ float gelu_tanh(float x) { const float u = 0.7978845608028654f * (x + 0.044715f * x * x * x); const float e = __builtin_amdgcn_exp2f(2.0f * LOG2E * u); const float th = 1.0f - 2.0f * __builtin_amdgcn_rcpf(e + 1.0f); return 0.5f * x * (1.0f + th); }
__device__ __forceinline__ void unpack8(const u32x4 w, float (&f)[8]) { f[0] = bf_lo(w.x); f[1] = bf_hi(w.x); f[2] = bf_lo(w.y); f[3] = bf_hi(w.y); f[4] = bf_lo(w.z); f[5] = bf_hi(w.z); f[6] = bf_lo(w.w); f[7] = bf_hi(w.w); }
__device__ __forceinline__ u32x4 pack8(const float (&f)[8]) { u32x4 w; w.x = cvt_pk_bf16(f[0], f[1]); w.y = cvt_pk_bf16(f[2], f[3]); w.z = cvt_pk_bf16(f[4], f[5]); w.w = cvt_pk_bf16(f[6], f[7]); return w; }

__global__ void __launch_bounds__(NTHREADS) mk_fwd(Params P) {
    extern __shared__ __attribute__((aligned(16))) unsigned char lds_raw[];
    LAS unsigned char* lds = (LAS unsigned char*)lds_raw;
    cg::grid_group grid = cg::this_grid();
    const int G = gridDim.x, bx = blockIdx.x;
    const int NGW = G * 8, NGT = G * NTHREADS;
    unsigned char* ws = P.ws;
    float* out = P.out;
    bf16_t* Wb = (bf16_t*)(ws + WS_W);
    bf16_t* XN = (bf16_t*)(ws + WS_XN);
    unsigned char* big = ws + WS_BIG;
    float* rope_tab = (float*)(ws + WS_ROPE);
    float* aggP = (float*)(ws + WS_AGG); float* aggH = aggP + 512 * 1024; float* aggC = aggH + 512 * 1024;
    float* part = aggP;
    const int lo = P.ph_lo, hi = P.ph_hi;
    int ph = 0;
    volatile LAS unsigned* bst = (volatile LAS unsigned*)(lds + LDS_BYTES - 64);
    if (threadIdx.x < 8) bst[threadIdx.x] = 0u;
    __syncthreads();
    XcdBarrier xbar; xbar.bar = (unsigned*)(ws + WS_BAR); xbar.x = xb_xcc_id(); xbar.st = bst;
    if (threadIdx.x == 0) { bst[4] = xb_add(&xbar.bar[XB_XCNT(xbar.x)], 1u);
        bst[2] = (unsigned)bx; bst[3] = (unsigned)((G % 8 == 0) ? (bx % 8) * (G / 8) + bx / 8 : bx); }
    __syncthreads();
#define BEGIN_PH if (ph >= lo && ph < hi) { int tid = threadIdx.x; asm volatile("" : "+v"(tid)); const int lane = tid & 63, wave = __builtin_amdgcn_readfirstlane(tid >> 6); \
        const int cidx = __builtin_amdgcn_readfirstlane((int)bst[2]); const unsigned pw_ = (unsigned)__builtin_amdgcn_readfirstlane((int)bst[3]); const int vcu = (int)(pw_ & 0xffffu); const bool xl_ok = (pw_ >> 16) != 0u; \
        const int gw = vcu * 8 + wave, gt = bx * NTHREADS + tid; (void)lane; (void)gw; (void)gt; (void)cidx; (void)xl_ok;
#define END_PH_X(loc_) if (ph + 1 < hi) { if (ph == 0) grid.sync(); else if (xl_ok && (loc_)) xcd_local_barrier(xbar, (unsigned)(G / 8)); else xcd_barrier(xbar); } } ++ph;
#define END_PH   END_PH_X(false)

    BEGIN_PH
    {
        LAS float* scr = (LAS float*)(lds + wave * 16640);
        constexpr int N_FFN = 24 * 704, N_EV = 2 * 952, N_OD = 2 * 704, N_ALL = N_FFN + N_EV + N_OD;
#define PREP_DECODE(it_, J_) do { const int it = (it_); \
            const float* W; int K, N, mode; const float* gain = nullptr; float scale = 1.f; bf16_t* WT; int r; \
            if (it < N_FFN) { const int j = it / 704; r = it % 704; const int f = j / 3, w = j % 3; \
                if (w < 2) { W = P.in[w == 0 ? I_FFN_G : I_FFN_U] + (size_t)f * DM * FF; K = DM; N = FF; gain = P.in[I_FFN_NORM] + f * DM; mode = 1 + w; WT = Wb + W_GU + f * W_GU_SZ; } \
                else { W = P.in[I_FFN_D] + (size_t)f * FF * DM; K = FF; N = DM; mode = 0; WT = Wb + W_DN + f * W_DN_SZ; } } \
            else if (it < N_FFN + N_EV) { const int i2 = it - N_FFN; const int jj = i2 / 952; r = i2 % 952; \
                if (r < 560) { W = P.in[I_EV_IN] + (size_t)jj * DM * EV_IN; K = DM; N = EV_IN; gain = P.in[I_MIX_NORM] + (2 * jj) * DM; mode = 4; WT = Wb + W_EVIN + jj * W_EVIN_SZ; } \
                else if (r < 632) { r -= 560; W = P.in[I_W_UQ] + (size_t)jj * 384 * 768; K = 384; N = 768; gain = P.in[I_Q_NORM] + jj * 384; mode = 3; scale = 0.10206207261596575f * LOG2E; WT = Wb + W_UQ + jj * W_UQ_SZ; } \
                else if (r < 696) { r -= 632; W = P.in[I_W_UKV] + (size_t)jj * 256 * 1024; K = 256; N = 1024; gain = P.in[I_KV_NORM] + jj * 256; mode = 0; WT = Wb + W_UKV + jj * W_UKV_SZ; } \
                else { r -= 696; W = P.in[I_EV_OUT] + (size_t)jj * DM * DM; K = DM; N = DM; mode = 0; WT = Wb + W_EVOUT + jj * W_SQ_SZ; } } \
            else { const int i2 = it - N_FFN - N_EV; const int jj = i2 / 704; r = i2 % 704; \
                if (r < 448) { W = P.in[I_OD_IN] + (size_t)jj * DM * OD_IN; K = DM; N = OD_IN; gain = P.in[I_MIX_NORM] + (2 * jj + 1) * DM; mode = 5; WT = Wb + W_ODIN + jj * W_ODIN_SZ; } \
                else { r -= 448; W = P.in[I_OD_OUT] + (size_t)jj * DM * DM; K = DM; N = DM; mode = 0; WT = Wb + W_ODOUT + jj * W_SQ_SZ; } } \
            const int nblk = (N + 63) / 64, kb = r / nblk, nb = r % nblk; \
            if (mode == 5 && nb >= 16 && nb < 24) scale = 0.125f * LOG2E;     \
            (J_) = PrepJob{W, gain, WT, scale, N, K, mode, kb, nb}; } while (0)
        for (int it0 = gw; it0 < N_ALL; it0 += 2 * NGW) {
            PrepJob ja, jb; f32x4 va[16], vb[16]; const bool hb = it0 + NGW < N_ALL;
            PREP_DECODE(it0, ja); prep_load(ja, lane, va);
            if (hb) { PREP_DECODE(it0 + NGW, jb); prep_load(jb, lane, vb); }
            prep_store(ja, lane, va, scr);
            if (hb) prep_store(jb, lane, vb, scr);
        }
#undef PREP_DECODE
        for (int i = gt; i < 2 * 96 * 1024 / 8; i += NGT) { const int jj = i / (96 * 128), rr = i % (96 * 128); *(u32x4*)(Wb + W_EVIN + jj * W_EVIN_SZ + (size_t)EV_IN * 1024 + (size_t)rr * 8) = (u32x4){0u, 0u, 0u, 0u}; }
        for (int i = gt; i < 2 * 2048 * 64; i += NGT) { const int jj = i / (2048 * 64), rr = (i / 64) % 2048, cc = (i % 64) * 8;
            const int unit = rr >> 8, gate = (rr >> 7) & 1, c = (unit & 3) * 128 + (rr & 127), dir = unit >> 2, nb = c >> 6, d = c & 63;
            u32x4 w = (u32x4){0u, 0u, 0u, 0u};
            if ((cc >> 6) == nb) { const float* src = P.in[gate ? I_LRU_WX : I_LRU_WA] + ((((size_t)jj * 2 + dir) * 8 + nb) * 64 + (cc & 63)) * 64 + d; float f[8];
#pragma unroll
                for (int j = 0; j < 8; ++j) f[j] = src[j * 64];
                w = pack8(f); }
            *(u32x4*)(Wb + W_LRU + jj * W_LRU_SZ + (size_t)rr * 512 + cc) = w; }
        for (int i = gt; i < 8192 * 16; i += NGT) { const int pos = i >> 4, fi = i & 15;
            const double inv = exp2(-(double)fi * (13.287712379549449 / 16.0));
            const double rev = (double)pos * inv * 0.15915494309189535; const float fr = (float)(rev - rint(rev));
            rope_tab[2 * i] = __builtin_amdgcn_cosf(fr); rope_tab[2 * i + 1] = __builtin_amdgcn_sinf(fr); }
        norm_phase(P.in[I_XP], P.in[I_XS], XN, part, gw, NGW, lane);
    }
    END_PH
    if (hi - lo > 1 && (G % 8) == 0) {
        bool ok = true;
#pragma unroll
        for (unsigned j = 0; j < 16; ++j) { const unsigned c = xb_ld(&xbar.bar[XB_XCNT(j)]); ok = ok && (c == (j < 8 ? (unsigned)(G / 8) : 0u)); }
        if (__builtin_amdgcn_readfirstlane((int)ok) != 0) {
            if (threadIdx.x == 0) { const unsigned rk = bst[4]; bst[2] = rk * 8u + xbar.x; bst[3] = (xbar.x * (unsigned)(G / 8) + rk) | (1u << 16); }
            __syncthreads();
        }
    }

#pragma unroll 1
    for (int l = 0; l < 4; ++l) {
        const int jj = l >> 1;
#pragma unroll 1
        for (int sub = 0; sub < 3; ++sub) {
            if (sub != 1) {
                const int f = l * 2 + (sub >> 1);
                BEGIN_PH { pg8::EpiSwiglu E{(bf16_t*)(big + B_ACT), part}; run_gemm<pg8::EpiSwiglu, true>(lds, XN, DM, Wb + W_GU + f * W_GU_SZ, 5632, DM, E, cidx); } END_PH_X(true)
                BEGIN_PH { pg8::EpiRes E{XN, part, 0.5f};
                    run_gemm<pg8::EpiRes, true>(lds, (const bf16_t*)(big + B_ACT), FF, Wb + W_DN + f * W_DN_SZ, DM, FF, E, cidx); } END_PH_X(sub == 0 || l < 3)
            } else if ((l & 1) == 0) {
                bf16_t* Z = (bf16_t*)(big + B_Z); bf16_t* Q = (bf16_t*)((unsigned char*)out + O_Q); bf16_t* KPE = (bf16_t*)((unsigned char*)out + O_KPE); bf16_t* KV = (bf16_t*)out;
                BEGIN_PH { pg8::EpiStore<true> E{Z, ZLD, part}; run_gemm<pg8::EpiStore<true>, true>(lds, XN, DM, Wb + W_EVIN + jj * W_EVIN_SZ, EV_INP, DM, E, cidx); } END_PH
                BEGIN_PH {
                    const float* cw = P.in[I_EV_CONV] + jj * 3 * 512;
                    float w0[8], w1[8], w2[8];
#pragma unroll
                    for (int j = 0; j < 8; ++j) { w0[j] = cw[lane * 8 + j]; w1[j] = cw[512 + lane * 8 + j]; w2[j] = cw[1024 + lane * 8 + j]; }
                    const int CH = (T + NGW - 1) / NGW; const int t0 = gw * CH, t1 = (t0 + CH < T) ? t0 + CH : T;
                    if (t0 < t1) {
                        float gp[8], gc[8], ta[8], tb[8];
                        { const bf16_t* zr = Z + (size_t)t0 * ZLD; unpack8(*(const u32x4*)(zr + 512 + lane * 8), ta); unpack8(*(const u32x4*)(zr + 1024 + lane * 8), tb);
#pragma unroll
                          for (int j = 0; j < 8; ++j) gc[j] = ta[j] * tb[j];
                          if (t0 > 0) { unpack8(*(const u32x4*)(zr - ZLD + 512 + lane * 8), ta); unpack8(*(const u32x4*)(zr - ZLD + 1024 + lane * 8), tb); }
#pragma unroll
                          for (int j = 0; j < 8; ++j) gp[j] = t0 > 0 ? ta[j] * tb[j] : 0.f; }
                        u32x4 rbg, rql, rkl, rcn, rxn; unsigned rkr;
#define EV_PREFETCH(t_) do { const bf16_t* z_ = Z + (size_t)(t_) * ZLD; rbg = *(const u32x4*)(z_ + lane * 8); rql = *(const u32x4*)(z_ + 1536 + (lane < 48 ? lane : 0) * 8); \
                            rkl = *(const u32x4*)(z_ + 1920 + (lane & 31) * 8); rkr = *(const unsigned*)(z_ + 2176 + (lane & 15) * 2); \
                            if ((t_) + 1 < T) { rcn = *(const u32x4*)(z_ + ZLD + 512 + lane * 8); rxn = *(const u32x4*)(z_ + ZLD + 1024 + lane * 8); } else { rcn = (u32x4){0u, 0u, 0u, 0u}; rxn = rcn; } } while (0)
                        EV_PREFETCH(t0);
                        for (int m = t0; m < t1; ++m) {
                            const int S = m < TP ? 8192 : 4096, pos = m & (S - 1);
                            bf16_t* zr = Z + (size_t)m * ZLD;
                            const u32x4 cbg = rbg, cql = rql, ckl = rkl, ccn = rcn, cxn = rxn; const unsigned krw = rkr;
                            if (m + 1 < t1) EV_PREFETCH(m + 1);
                            float bg[8], gn[8], acc8[8];
                            unpack8(cbg, bg); unpack8(ccn, ta); unpack8(cxn, tb);
#pragma unroll
                            for (int j = 0; j < 8; ++j) gn[j] = ta[j] * tb[j];
                            const float fp = pos > 0 ? 1.f : 0.f, fn = pos < S - 1 ? 1.f : 0.f;
#pragma unroll
                            for (int j = 0; j < 8; ++j) acc8[j] = bg[j] * (w1[j] * gc[j] + fp * w0[j] * gp[j] + fn * w2[j] * gn[j]);
                            float ql[8], kl[8]; float sq = 0.f, sk = 0.f;
                            unpack8(cql, ql); unpack8(ckl, kl);
#pragma unroll
                            for (int j = 0; j < 8; ++j) { sq += ql[j] * ql[j]; sk += kl[j] * kl[j]; }
                            if (lane >= 48) sq = 0.f;
                            if (lane >= 32) sk = 0.f;
                            sq = wave_sum(sq); sk = wave_sum(sk);
                            const float rq = rsqrtf(sq * (1.f / 384.f) + EPS), rk = rsqrtf(sk * (1.f / 256.f) + EPS);
                            *(u32x4*)(zr + lane * 8) = pack8(acc8);
                            if (lane < 48) {
#pragma unroll
                                for (int j = 0; j < 8; ++j) ql[j] *= rq;
                                *(u32x4*)(zr + 1536 + lane * 8) = pack8(ql); }
                            if (lane < 32) {
#pragma unroll
                                for (int j = 0; j < 8; ++j) kl[j] *= rk;
                                *(u32x4*)(zr + 1920 + lane * 8) = pack8(kl); }
                            if (lane < 16) { const float x1 = bf_lo(krw), x2 = bf_hi(krw); const f32x2 cs = *(const f32x2*)(rope_tab + ((size_t)pos * 16 + lane) * 2);
                                *(unsigned*)(KPE + (size_t)m * 32 + lane * 2) = cvt_pk_bf16(x1 * cs.x - x2 * cs.y, x1 * cs.y + x2 * cs.x); }
#pragma unroll
                            for (int j = 0; j < 8; ++j) { gp[j] = gc[j]; gc[j] = gn[j]; }
                        }
#undef EV_PREFETCH
                    }
                } END_PH_X(true)
                BEGIN_PH {
                    { pg8::EpiQRope E{Q, rope_tab}; run_gemm<pg8::EpiQRope, true>(lds, Z + 1536, ZLD, Wb + W_UQ + jj * W_UQ_SZ, 768, 384, E, cidx); }
                    { pg8::EpiStore<false> E{KV, 1024, nullptr}; run_gemm<pg8::EpiStore<false>, true>(lds, Z + 1920, ZLD, Wb + W_UKV + jj * W_UKV_SZ, 1024, 256, E, cidx); }
                } END_PH
                BEGIN_PH {
                    for (int u = vcu; u < 1024; u += G) {
                        int seq0, S, h, qb;
                        if (u < 512) { const int sh = u >> 5; qb = u & 31; seq0 = (sh >> 3) * 8192; S = 8192; h = sh & 7; }
                        else { const int u2 = u - 512, sh = u2 >> 4; qb = u2 & 15; seq0 = TP + (sh >> 3) * 4096; S = 4096; h = sh & 7; }
                        att::Unit a; const size_t r0 = (size_t)seq0 + qb * 256;
                        a.Q = Q + r0 * 768 + h * 96; a.ldq = 768; a.K = KV + (size_t)seq0 * 1024 + h * 128; a.ldk = 1024; a.KPE = KPE + (size_t)seq0 * 32;
                        a.V = KV + (size_t)seq0 * 1024 + h * 128 + 64; a.ldv = 1024; a.O = Z + r0 * ZLD + 512 + h * 64; a.ldo = ZLD;
                        a.t_lo = 0; a.t_hi = S / 64; a.qpos0 = qb * 256; a.slope2 = 0.f; a.sink2 = 0.f;
                        att::attn_unit<0>(a, (char*)lds_raw);
                    }
                } END_PH
                BEGIN_PH { pg8::EpiRes E{XN, part, 1.0f}; run_gemm<pg8::EpiRes, true>(lds, Z, ZLD, Wb + W_EVOUT + jj * W_SQ_SZ, DM, DM, E, cidx); } END_PH_X(true)
            } else {
                bf16_t* Z2 = (bf16_t*)(big + B_Z2); bf16_t* XC = (bf16_t*)(big + B_XC); bf16_t* U = (bf16_t*)((unsigned char*)out + O_U); bf16_t* LA = (bf16_t*)out;
                BEGIN_PH { pg8::EpiStore<true> E{Z2, ZLD, part}; run_gemm<pg8::EpiStore<true>, true>(lds, XN, DM, Wb + W_ODIN + jj * W_ODIN_SZ, OD_IN, DM, E, cidx); } END_PH
                BEGIN_PH {
                    const float* cw = P.in[I_OD_CONV] + jj * 4 * 512; const float* cb = P.in[I_OD_CONVB] + jj * 512;
                    float w4[4][8], bb[8];
#pragma unroll
                    for (int j = 0; j < 8; ++j) { bb[j] = cb[lane * 8 + j];
#pragma unroll
                        for (int k = 0; k < 4; ++k) w4[k][j] = cw[k * 512 + lane * 8 + j]; }
                    const int CH = (T + NGW - 1) / NGW; const int t0 = gw * CH, t1 = (t0 + CH < T) ? t0 + CH : T;
                    if (t0 < t1) {
                        const u32x4 zero4 = (u32x4){0u, 0u, 0u, 0u};
                        const bf16_t* z0 = Z2 + (size_t)t0 * ZLD + lane * 8;
                        u32x4 r0 = t0 >= 2 ? *(const u32x4*)(z0 - 2 * ZLD) : zero4, r1 = t0 >= 1 ? *(const u32x4*)(z0 - ZLD) : zero4, r2 = *(const u32x4*)z0;
                        u32x4 r3 = (t0 + 1 < T) ? *(const u32x4*)(z0 + ZLD) : zero4;
                        for (int m = t0; m < t1; ++m) {
                            const int S = m < TP ? 8192 : 4096, pos = m & (S - 1);
                            const u32x4 nx = (m + 2 < T) ? *(const u32x4*)(Z2 + (size_t)(m + 2) * ZLD + lane * 8) : zero4;
                            float x0[8], x1[8], x2[8], x3[8], a8[8];
                            unpack8(r0, x0); unpack8(r1, x1); unpack8(r2, x2); unpack8(r3, x3);
                            const float f0 = pos >= 2 ? 1.f : 0.f, f1 = pos >= 1 ? 1.f : 0.f, f3 = pos < S - 1 ? 1.f : 0.f;
#pragma unroll
                            for (int j = 0; j < 8; ++j) a8[j] = bb[j] + w4[2][j] * x2[j] + f0 * w4[0][j] * x0[j] + f1 * w4[1][j] * x1[j] + f3 * w4[3][j] * x3[j];
                            *(u32x4*)(XC + (size_t)m * 512 + lane * 8) = pack8(a8);
                            r0 = r1; r1 = r2; r2 = r3; r3 = nx;
                        }
                    }
                } END_PH_X(true)
                BEGIN_PH { pg8::EpiLru E{LA, U, XC, P.in[I_LRU_BA] + jj * 1024, P.in[I_LRU_BX] + jj * 1024, P.in[I_LRU_LAM] + jj * 1024};
                    run_gemm<pg8::EpiLru, true>(lds, XC, 512, Wb + W_LRU + jj * W_LRU_SZ, 2048, 512, E, cidx, 128); } END_PH
                BEGIN_PH {
                    for (int it = gt; it < 512 * 512; it += NGT) { const int ch = it >> 9, cp = it & 511, col = cp * 2; const bool bwd = col >= 512;
                        const size_t base = (size_t)ch * 64 * 1024 + col;
                        float h0 = 0.f, h1 = 0.f, s0 = 0.f, s1 = 0.f;
#pragma unroll 8
                        for (int i = 0; i < 64; ++i) { const int tt = bwd ? 63 - i : i; const unsigned lw = *(const unsigned*)(LA + base + (size_t)tt * 1024), uw = *(const unsigned*)(U + base + (size_t)tt * 1024);
                            const float l0 = bf_lo(lw), l1 = bf_hi(lw); s0 += l0; s1 += l1;
                            h0 = __builtin_amdgcn_exp2f(l0) * h0 + bf_lo(uw); h1 = __builtin_amdgcn_exp2f(l1) * h1 + bf_hi(uw); }
                        *(f32x2*)(aggP + (size_t)ch * 1024 + col) = (f32x2){__builtin_amdgcn_exp2f(s0), __builtin_amdgcn_exp2f(s1)};
                        *(f32x2*)(aggH + (size_t)ch * 1024 + col) = (f32x2){h0, h1}; }
                } END_PH
                BEGIN_PH {
                    for (int it = gt; it < 6 * 1024; it += NGT) { const int sq = it >> 10, col = it & 1023; const bool bwd = col >= 512;
                        const int c0 = sq < 2 ? sq * 128 : 256 + (sq - 2) * 64, nc = sq < 2 ? 128 : 64;
                        float c = 0.f;
                        for (int i0 = 0; i0 < nc; i0 += 8) { float p[8], hh[8];
#pragma unroll
                            for (int j = 0; j < 8; ++j) { const int ch = c0 + (bwd ? nc - 1 - (i0 + j) : i0 + j); p[j] = aggP[(size_t)ch * 1024 + col]; hh[j] = aggH[(size_t)ch * 1024 + col]; }
#pragma unroll
                            for (int j = 0; j < 8; ++j) { const int ch = c0 + (bwd ? nc - 1 - (i0 + j) : i0 + j); aggC[(size_t)ch * 1024 + col] = c; c = p[j] * c + hh[j]; } }
                    }
                } END_PH
                BEGIN_PH {
                    for (int it = gt; it < 512 * 256; it += NGT) { const int ch = it >> 8, cp = it & 255, col = cp * 2;
                        const size_t base = (size_t)ch * 64 * 1024 + col;
                        unsigned hfp[64];
                        { const f32x2 cf = *(const f32x2*)(aggC + (size_t)ch * 1024 + col); float h0 = cf.x, h1 = cf.y;
#pragma unroll
                          for (int b = 0; b < 8; ++b) { unsigned lw[8], uw[8];
#pragma unroll
                              for (int j = 0; j < 8; ++j) { const size_t ix = base + (size_t)(b * 8 + j) * 1024; lw[j] = *(const unsigned*)(LA + ix); uw[j] = *(const unsigned*)(U + ix); }
#pragma unroll
                              for (int j = 0; j < 8; ++j) { h0 = __builtin_amdgcn_exp2f(bf_lo(lw[j])) * h0 + bf_lo(uw[j]); h1 = __builtin_amdgcn_exp2f(bf_hi(lw[j])) * h1 + bf_hi(uw[j]); hfp[b * 8 + j] = cvt_pk_bf16(h0, h1); } } }
                        { const f32x2 cf = *(const f32x2*)(aggC + (size_t)ch * 1024 + 512 + col); float h0 = cf.x, h1 = cf.y;
#pragma unroll
                          for (int b = 7; b >= 0; --b) { unsigned lw[8], uw[8], gwd[8];
#pragma unroll
                              for (int j = 0; j < 8; ++j) { const size_t ix = base + (size_t)(b * 8 + j) * 1024 + 512; lw[j] = *(const unsigned*)(LA + ix); uw[j] = *(const unsigned*)(U + ix);
                                  gwd[j] = *(const unsigned*)(Z2 + (size_t)(ch * 64 + b * 8 + j) * ZLD + col + 1024); }
#pragma unroll
                              for (int j = 7; j >= 0; --j) { h0 = __builtin_amdgcn_exp2f(bf_lo(lw[j])) * h0 + bf_lo(uw[j]); h1 = __builtin_amdgcn_exp2f(bf_hi(lw[j])) * h1 + bf_hi(uw[j]);
                                  const unsigned hf = hfp[b * 8 + j];
                                  *(unsigned*)(Z2 + (size_t)(ch * 64 + b * 8 + j) * ZLD + col) = cvt_pk_bf16(gelu_tanh(bf_lo(gwd[j])) * (bf_lo(hf) + h0), gelu_tanh(bf_hi(gwd[j])) * (bf_hi(hf) + h1)); } } }
                    }
                    for (int u = vcu; u < 1024; u += G) { const int rb = u >> 3, h = u & 7; const size_t r0 = (size_t)rb * 256;
                        const int S = r0 < TP ? 8192 : 4096; const int qpos0 = (int)(r0 & (size_t)(S - 1)); const size_t seq0 = r0 - qpos0;
                        att::Unit a; a.Q = Z2 + r0 * ZLD + 512 + h * 64; a.ldq = ZLD; a.K = Z2 + seq0 * ZLD + 1536 + (h >> 2) * 64; a.ldk = ZLD; a.KPE = nullptr;
                        a.V = Z2 + seq0 * ZLD + 1664 + (h >> 2) * 64; a.ldv = ZLD; a.O = Z2 + r0 * ZLD + 512 + h * 64; a.ldo = ZLD;
                        a.t_lo = max(0, qpos0 / 64 - 2); a.t_hi = min(S / 64, qpos0 / 64 + 6); a.qpos0 = qpos0;
                        a.slope2 = exp2f(-(float)(h + 1)) * LOG2E; a.sink2 = P.in[I_SINK][jj * 8 + h] * LOG2E;
                        att::attn_unit<1>(a, (char*)lds_raw);
                    }
                } END_PH
                BEGIN_PH { pg8::EpiRes E{XN, part, 1.0f}; run_gemm<pg8::EpiRes, true>(lds, Z2, ZLD, Wb + W_ODOUT + jj * W_SQ_SZ, DM, DM, E, cidx); } END_PH_X(true)
            }
        }
    }
    BEGIN_PH {
        const float* gn = P.in[I_FINAL_NORM];
        f32x4 g4[4];
#pragma unroll
        for (int j = 0; j < 4; ++j) g4[j] = *((const f32x4*)gn + lane + 64 * j);
        for (int m = gw; m < T; m += NGW) { const u32x2* xr = (const u32x2*)(XN + (size_t)m * DM) + lane; f32x4 v[4]; float s = 0.f;
#pragma unroll
            for (int j = 0; j < 4; ++j) { const u32x2 w = xr[64 * j]; v[j] = (f32x4){bf_lo(w.x), bf_hi(w.x), bf_lo(w.y), bf_hi(w.y)}; s += (v[j].x * v[j].x + v[j].y * v[j].y) + (v[j].z * v[j].z + v[j].w * v[j].w); }
            const float rstd = rsqrtf(wave_sum(s) * (1.f / DM) + EPS);
            f32x4* orow = (f32x4*)(out + (size_t)m * DM) + lane;
#pragma unroll
            for (int j = 0; j < 4; ++j) orow[64 * j] = v[j] * rstd * g4[j]; }
    } END_PH
#undef BEGIN_PH
#undef END_PH
#undef END_PH_X
}

constexpr int N_PHASES = 1 + 4 * (2 + 2) + 2 * 5 + 2 * 7 + 1;

extern "C" void kernel_launch(void* const* d_in, const int* in_sizes, int n_in, void* d_out, int out_size, void* d_ws, size_t ws_size, hipStream_t stream) {
    static int grid = 0;
    if (grid == 0) {
        if (n_in != 25 || out_size != T * DM || ws_size < WS_END) { fprintf(stderr, "kernel_launch: unexpected sizes n_in %d out %d ws %zu\n", n_in, out_size, ws_size); grid = -1; return; }
        int dev = 0, cus = 0, per_cu = 0;
        hipGetDevice(&dev); hipDeviceGetAttribute(&cus, hipDeviceAttributeMultiprocessorCount, dev);
        hipFuncSetAttribute((const void*)mk_fwd, hipFuncAttributeMaxDynamicSharedMemorySize, LDS_BYTES);
        hipOccupancyMaxActiveBlocksPerMultiprocessor(&per_cu, (const void*)mk_fwd, NTHREADS, LDS_BYTES);
        if (per_cu < 1) per_cu = 1;
        grid = cus * per_cu;
        (void)hipGetLastError();
    }
    if (grid < 0) return;
    Params p{};
    for (int i = 0; i < 25; ++i) p.in[i] = (const float*)d_in[i];
    p.out = (float*)d_out; p.ws = (unsigned char*)d_ws;
    (void)hipMemsetAsync((unsigned char*)d_ws + WS_BAR, 0, BAR_BYTES, stream);
#if MK_MULTI
    for (int ph = 0; ph < N_PHASES; ++ph) { p.ph_lo = ph; p.ph_hi = ph + 1; hipLaunchKernelGGL(mk_fwd, dim3(grid), dim3(NTHREADS), LDS_BYTES, stream, p); }
#else
    p.ph_lo = 0; p.ph_hi = N_PHASES;
    void* args[] = {&p};
    hipError_t e = hipLaunchCooperativeKernel((const void*)mk_fwd, dim3(grid), dim3(NTHREADS), args, LDS_BYTES, stream);
    if (e != hipSuccess) fprintf(stderr, "cooperative launch failed: %s (grid %d)\n", hipGetErrorString(e), grid);
#endif
}
```
